# Optimizing an MI355X kernel written in HIP

```python
import math
import jax, jax.numpy as jnp
from jax import lax
import numpy as np


D_MODEL = 1024
BATCH = 8
SEQ = 2048
DEPTH = 1
DEC_BATCH = 128
DEC_SEQ = 4
PAST_LEN = 16384
PAGE_SIZE = 128

D_MIX = D_MODEL
MIX_A = D_MIX // 2
A_HEADS = 4
A_DK = MIX_A // A_HEADS
A_DV = MIX_A // A_HEADS
MIX_B = D_MIX - MIX_A
CONV_W = 31
D_IN = 4 * MIX_A + 2 * MIX_B
D_FF = ((8 * D_MODEL + 3 * 256 - 1) // (3 * 256)) * 256
D_PLE = 256
CHUNK = 32
EPS = 1e-6

kernel_name = "hymba_hgrn2_conformer_conv_decode_step"


def _rmsnorm(x, g):
    xf = x.astype(jnp.float32)
    return xf * lax.rsqrt(jnp.mean(xf * xf, axis=-1, keepdims=True) + EPS) * g.astype(jnp.float32)


def _hgrn2_scan(q, k, v, logf, s0):
    B, T, H, DK = q.shape
    DV = v.shape[-1]
    C = math.gcd(T, CHUNK)
    n = T // C

    def to_chunks(a):
        return a.reshape(B, n, C, H, a.shape[-1]).transpose(1, 0, 3, 2, 4)

    qc, kc, vc, gc = to_chunks(q), to_chunks(k), to_chunks(v), to_chunks(logf)
    mask = jnp.tril(jnp.ones((C, C), dtype=bool))

    def step(s, inp):
        qi, ki, vi, gi = inp
        b = jnp.cumsum(gi, axis=2)
        b_last = b[:, :, -1:, :]
        q_dec = qi * jnp.exp(b)
        k_inv = ki * jnp.exp(-b)
        o_inter = jnp.einsum('bhtk,bhkv->bhtv', q_dec, s)
        scores = jnp.where(mask, jnp.einsum('bhtk,bhsk->bhts', q_dec, k_inv), 0.0)
        o_intra = jnp.einsum('bhts,bhsv->bhtv', scores, vi)
        s_new = jnp.exp(b_last[:, :, 0, :])[..., None] * s + jnp.einsum(
            'bhsk,bhsv->bhkv', ki * jnp.exp(b_last - b), vi)
        return s_new, o_inter + o_intra

    s_fin, o = lax.scan(step, s0, (qc, kc, vc, gc))
    o = o.transpose(1, 0, 3, 2, 4).reshape(B, T, H, DV)
    return o, s_fin


def _layer(h, p_l, s0, buf0, lb, norm_mix, w_in, hgrn_out_norm, conv_dw, conv_dw_bias,
           conv_ln_gain, conv_ln_bias, w_out, norm_ffn, w_ffn_gate, w_ffn_up, w_ffn_down,
           norm_ple, w_ple_gate, w_ple_proj):
    f32 = jnp.float32
    B, T, _ = h.shape
    xn = _rmsnorm(h, norm_mix)
    proj = xn @ w_in.astype(f32)
    q = proj[..., 0 * MIX_A:1 * MIX_A]
    fg = proj[..., 1 * MIX_A:2 * MIX_A]
    iv = proj[..., 2 * MIX_A:3 * MIX_A]
    og = proj[..., 3 * MIX_A:4 * MIX_A]
    ca = proj[..., 4 * MIX_A:4 * MIX_A + MIX_B]
    cg = proj[..., 4 * MIX_A + MIX_B:]

    def heads(a):
        return a.reshape(B, T, A_HEADS, -1)

    forget = lb + (1.0 - lb) * jax.nn.sigmoid(fg)
    o, s_new = _hgrn2_scan(heads(jax.nn.silu(q)), heads(1.0 - forget), heads(iv),
                           heads(jnp.log(forget)), s0.astype(f32))
    o = _rmsnorm(o, hgrn_out_norm) * jax.nn.silu(heads(og))
    o_a = o.reshape(B, T, MIX_A)

    u = ca * jax.nn.sigmoid(cg)
    u_full = jnp.concatenate([buf0.astype(f32), u], axis=1)
    z = lax.conv_general_dilated(u_full, conv_dw.astype(f32)[:, None, :], window_strides=(1,),
                                 padding='VALID', dimension_numbers=('NWC', 'WIO', 'NWC'),
                                 feature_group_count=MIX_B) + conv_dw_bias.astype(f32)
    mu = jnp.mean(z, axis=-1, keepdims=True)
    var = jnp.mean(jnp.square(z - mu), axis=-1, keepdims=True)
    z = (z - mu) * lax.rsqrt(var + EPS) * conv_ln_gain.astype(f32) + conv_ln_bias.astype(f32)
    o_b = jax.nn.silu(z)
    buf_new = u_full[:, T:, :]

    h = h + jnp.concatenate([o_a, o_b], axis=-1) @ w_out.astype(f32)

    xn2 = _rmsnorm(h, norm_ffn)
    h = h + (jax.nn.silu(xn2 @ w_ffn_gate.astype(f32)) * (xn2 @ w_ffn_up.astype(f32))) @ w_ffn_down.astype(f32)

    gate = jax.nn.sigmoid(_rmsnorm(h, norm_ple) @ w_ple_gate.astype(f32))
    h = h + gate * (p_l.astype(f32) @ w_ple_proj.astype(f32))
    return h, s_new, buf_new


def _trunk(x, p, st_hgrn, st_conv, norm_mix, w_in, lb_logits, hgrn_out_norm, conv_dw, conv_dw_bias,
           conv_ln_gain, conv_ln_bias, w_out, norm_ffn, w_ffn_gate, w_ffn_up, w_ffn_down,
           norm_ple, w_ple_gate, w_ple_proj, norm_final):
    h = x.astype(jnp.float32)
    lb_all = jnp.cumsum(jax.nn.softmax(lb_logits.astype(jnp.float32), axis=0), axis=0)
    new_s, new_c = [], []
    for l in range(DEPTH):
        h, s_l, c_l = _layer(h, p[l], st_hgrn[l], st_conv[l], lb_all[l], norm_mix[l], w_in[l],
                             hgrn_out_norm[l], conv_dw[l], conv_dw_bias[l], conv_ln_gain[l],
                             conv_ln_bias[l], w_out[l], norm_ffn[l], w_ffn_gate[l], w_ffn_up[l],
                             w_ffn_down[l], norm_ple[l], w_ple_gate[l], w_ple_proj[l])
        new_s.append(s_l)
        new_c.append(c_l)
    y = _rmsnorm(h, norm_final).astype(x.dtype)
    return y, jnp.stack(new_s, axis=0), jnp.stack(new_c, axis=0)


def setup_inputs(seed: int = 0) -> dict:
    key = jax.random.key(seed)
    ks = jax.random.split(key, 24)
    f32 = jnp.float32

    def nrm(k, shape, scale):
        return jax.random.normal(k, shape, f32) * scale

    return {
        "x_prompt": nrm(ks[0], (BATCH, SEQ, D_MODEL), 1.0),
        "x_sample": nrm(ks[1], (DEC_BATCH, DEC_SEQ, D_MODEL), 1.0),
        "p_prompt": nrm(ks[2], (DEPTH, BATCH, SEQ, D_PLE), 1.0),
        "p_sample": nrm(ks[3], (DEPTH, DEC_BATCH, DEC_SEQ, D_PLE), 1.0),
        "state_hgrn": nrm(ks[4], (DEPTH, DEC_BATCH, A_HEADS, A_DK, A_DV), 0.5),
        "state_conv": nrm(ks[5], (DEPTH, DEC_BATCH, CONV_W - 1, MIX_B), 0.5),
        "norm_mix": 1.0 + nrm(ks[6], (DEPTH, D_MODEL), 0.02),
        "w_in": nrm(ks[7], (DEPTH, D_MODEL, D_IN), D_MODEL ** -0.5),
        "lb_logits": nrm(ks[8], (DEPTH + 1, MIX_A), 0.1),
        "hgrn_out_norm": 1.0 + nrm(ks[9], (DEPTH, A_DV), 0.02),
        "conv_dw": nrm(ks[10], (DEPTH, CONV_W, MIX_B), CONV_W ** -0.5),
        "conv_dw_bias": nrm(ks[11], (DEPTH, MIX_B), 0.02),
        "conv_ln_gain": 1.0 + nrm(ks[12], (DEPTH, MIX_B), 0.02),
        "conv_ln_bias": nrm(ks[13], (DEPTH, MIX_B), 0.02),
        "w_out": nrm(ks[14], (DEPTH, D_MIX, D_MODEL), D_MIX ** -0.5),
        "norm_ffn": 1.0 + nrm(ks[15], (DEPTH, D_MODEL), 0.02),
        "w_ffn_gate": nrm(ks[16], (DEPTH, D_MODEL, D_FF), D_MODEL ** -0.5),
        "w_ffn_up": nrm(ks[17], (DEPTH, D_MODEL, D_FF), D_MODEL ** -0.5),
        "w_ffn_down": nrm(ks[18], (DEPTH, D_FF, D_MODEL), D_FF ** -0.5),
        "norm_ple": 1.0 + nrm(ks[19], (DEPTH, D_MODEL), 0.02),
        "w_ple_gate": nrm(ks[20], (DEPTH, D_MODEL, D_MODEL), D_MODEL ** -0.5),
        "w_ple_proj": nrm(ks[21], (DEPTH, D_PLE, D_MODEL), D_PLE ** -0.5),
        "norm_final": 1.0 + nrm(ks[22], (D_MODEL,), 0.02),
    }


def reference(x_prompt, x_sample, p_prompt, p_sample, state_hgrn, state_conv, norm_mix, w_in,
              lb_logits, hgrn_out_norm, conv_dw, conv_dw_bias, conv_ln_gain, conv_ln_bias, w_out,
              norm_ffn, w_ffn_gate, w_ffn_up, w_ffn_down, norm_ple, w_ple_gate, w_ple_proj,
              norm_final):
    B = x_prompt.shape[0]
    zero_s = jnp.zeros((DEPTH, B, A_HEADS, A_DK, A_DV), jnp.float32)
    zero_c = jnp.zeros((DEPTH, B, CONV_W - 1, MIX_B), jnp.float32)
    y_prompt, state_hgrn_prompt, state_conv_prompt = _trunk(
        x_prompt, p_prompt, zero_s, zero_c, norm_mix, w_in, lb_logits, hgrn_out_norm, conv_dw,
        conv_dw_bias, conv_ln_gain, conv_ln_bias, w_out, norm_ffn, w_ffn_gate, w_ffn_up,
        w_ffn_down, norm_ple, w_ple_gate, w_ple_proj, norm_final)
    y_sample, state_hgrn_sample, state_conv_sample = _trunk(
        x_sample, p_sample, state_hgrn, state_conv, norm_mix, w_in, lb_logits, hgrn_out_norm,
        conv_dw, conv_dw_bias, conv_ln_gain, conv_ln_bias, w_out, norm_ffn, w_ffn_gate, w_ffn_up,
        w_ffn_down, norm_ple, w_ple_gate, w_ple_proj, norm_final)
    return (y_prompt, y_sample, state_hgrn_prompt, state_conv_prompt, state_hgrn_sample, state_conv_sample)
```

```cpp
#include <hip/hip_runtime.h>
#include <hip/hip_cooperative_groups.h>
#include <cstdio>
#include <cstdint>
namespace cg = cooperative_groups;

namespace pg8 {
#define PG8_LAS __attribute__((address_space(3)))
typedef unsigned short bf16_t;
typedef short bf16x8 __attribute__((ext_vector_type(8)));
typedef float f32x4 __attribute__((ext_vector_type(4)));
typedef unsigned u32x4 __attribute__((ext_vector_type(4)));
typedef unsigned u32x2 __attribute__((ext_vector_type(2)));
constexpr int BM = 256, BK = 64, HALF = 128, HTB = HALF * BK * 2, STAGE_BYTES = 8 * HTB, NXCD = 8, WGM = 8;

__host__ __device__ __forceinline__ int lds_byte(int r, int c) { const int st = (r >> 4) * 2 + (c >> 5), rr = r & 15, cc = c & 31, ob = rr * 64 + cc * 2; return st * 1024 + (ob ^ (((ob >> 9) & 1) << 5)); }
__host__ __device__ __forceinline__ void stage_rc(int b, int& R, int& C) { const int st = b / 1024, sb = b % 1024, swz = sb ^ (((sb >> 9) & 1) << 5); R = (st >> 1) * 16 + swz / 64; C = (st & 1) * 32 + (swz % 64) / 2; }
__host__ __device__ __forceinline__ int perm32(int rho) { const int n = rho >> 4, i = rho & 15; return 8 * (i >> 2) + 4 * n + (i & 3); }

struct Unit { int pm, pn; };
struct Gemm { const bf16_t* A; const bf16_t* Bt; int M, N, K; };

struct StaticOrder {
    int nM, nN, nwg, G, c;
    __host__ __device__ void init(int M, int N, int G_, int c_) { nM = M / BM; nN = N / BM; nwg = nM * nN; G = G_; c = c_; }
    __host__ __device__ bool next(int i, Unit& u) const {
        const long L = (long)i * G + c; if (L >= nwg) return false;
        int wgid = (int)L; { const int q = nwg / NXCD, r = nwg % NXCD, xcd = wgid % NXCD, off = wgid / NXCD; wgid = (xcd < r ? xcd * (q + 1) : r * (q + 1) + (xcd - r) * q) + off; }
        const int nig = WGM * nN, gid = wgid / nig, fm = gid * WGM, gsz = (nM - fm) < WGM ? (nM - fm) : WGM;
        u.pm = fm + ((wgid % nig) % gsz); u.pn = (wgid % nig) / gsz; return true;
    }
    __device__ __forceinline__ void a_ready(const Unit&) const {}
    __device__ __forceinline__ void done(const Unit&) const {}
};

__device__ __forceinline__ unsigned cvt_pk_bf16(float lo, float hi) { unsigned r; asm volatile("v_cvt_pk_bf16_f32 %0, %1, %2" : "=v"(r) : "v"(lo), "v"(hi)); return r; }

template <class Epi, class Sched>
__device__ __forceinline__ void gemm_phase(PG8_LAS unsigned char* lds, const Gemm g, const Sched& S, const Epi& E) {
    int tid = threadIdx.x; asm volatile("" : "+v"(tid));
    const int wid = __builtin_amdgcn_readfirstlane(tid >> 6), lane = tid & 63, wr = wid >> 2, wc = wid & 3, fr = lane & 15, fq = lane >> 4;
    const int K = g.K, nt = K / BK;
    unsigned voffA[2], voffB[2];
#pragma unroll
    for (int i = 0; i < 2; ++i) { int R, C; stage_rc(tid * 16 + i * 8192, R, C); const int Rb = Epi::PERM ? ((R & ~31) + perm32(R & 31)) : R;
        voffA[i] = (unsigned)(R * K + C) * 2u; voffB[i] = (unsigned)(Rb * K + C) * 2u; }
    const size_t kstep = (size_t)(BK * 2);
    const size_t hstep = (size_t)HALF * K * 2;
    const size_t tstep = 2 * hstep;
    const unsigned ldsw = (unsigned)wid * 1024u;
    const int aoff = lds_byte(wr * 64 + fr, fq * 8), boff = lds_byte(wc * 32 + fr, fq * 8);
#define PG8_SA(b, h) (((b) * 2 + (h)) * HTB)
#define PG8_SB(b, h) ((4 + (b) * 2 + (h)) * HTB)
#define PG8_STAGE(bufoff, gbase, voff) do { _Pragma("unroll") for (int _i = 0; _i < 2; ++_i) \
        __builtin_amdgcn_global_load_lds((const unsigned*)((const char*)(gbase) + (voff)[_i]), (PG8_LAS unsigned*)(lds + (bufoff) + ldsw + _i * 8192), 16, 0, 0); } while (0)
#define PG8_LDA(dst, b, h) do { _Pragma("unroll") for (int m = 0; m < 4; ++m) _Pragma("unroll") for (int k = 0; k < 2; ++k) dst[m][k] = *(const PG8_LAS bf16x8*)(lds + PG8_SA(b, h) + aoff + m * 2048 + k * 1024); } while (0)
#define PG8_LDB(dst, b, h) do { _Pragma("unroll") for (int n = 0; n < 2; ++n) _Pragma("unroll") for (int k = 0; k < 2; ++k) dst[n][k] = *(const PG8_LAS bf16x8*)(lds + PG8_SB(b, h) + boff + n * 2048 + k * 1024); } while (0)
#define PG8_MMA(ai, bj, At, Bt) do { __builtin_amdgcn_s_setprio(1); _Pragma("unroll") for (int m = 0; m < 4; ++m) _Pragma("unroll") for (int n = 0; n < 2; ++n) _Pragma("unroll") for (int k = 0; k < 2; ++k) \
        acc[ai][bj][m][n] = __builtin_amdgcn_mfma_f32_16x16x32_bf16(Bt[n][k], At[m][k], acc[ai][bj][m][n], 0, 0, 0); __builtin_amdgcn_s_setprio(0); } while (0)
#define PG8_WAIT_V(n) asm volatile("s_waitcnt vmcnt(" #n ")" ::: "memory")
#define PG8_WAIT_L(n) asm volatile("s_waitcnt lgkmcnt(" #n ")" ::: "memory")
#define PG8_BAR __builtin_amdgcn_s_barrier()
#define PG8_SCHED __builtin_amdgcn_sched_barrier(0)
    Unit cur, nxt; int ui = 0;
    if (!S.next(0, cur)) return;
    f32x4 acc[2][2][4][2];
#pragma unroll
    for (int a = 0; a < 2; ++a)
#pragma unroll
        for (int b = 0; b < 2; ++b)
#pragma unroll
            for (int m = 0; m < 4; ++m)
#pragma unroll
                for (int n = 0; n < 2; ++n) acc[a][b][m][n] = (f32x4){0.f, 0.f, 0.f, 0.f};
    bf16x8 At[4][2], B0[2][2], B1[2][2];
    const char* cA = (const char*)g.A + (size_t)cur.pm * tstep; const char* cB = (const char*)g.Bt + (size_t)cur.pn * tstep;
    float epre[Epi::NPRE]; E.preload(cur, wr, fr, epre);
    S.a_ready(cur);
    PG8_STAGE(PG8_SB(0, 0), cB, voffB); PG8_STAGE(PG8_SA(0, 0), cA, voffA); PG8_STAGE(PG8_SB(0, 1), cB + hstep, voffB); PG8_STAGE(PG8_SA(0, 1), cA + hstep, voffA);
    if (wr == 1) PG8_BAR;
    PG8_WAIT_V(4); PG8_BAR;
    PG8_STAGE(PG8_SB(1, 0), cB + kstep, voffB); PG8_STAGE(PG8_SA(1, 0), cA + kstep, voffA); PG8_STAGE(PG8_SB(1, 1), cB + hstep + kstep, voffB);
    PG8_WAIT_V(6); PG8_BAR;
    for (;;) {
        const bool has_next = S.next(ui + 1, nxt);
        const char* nA = has_next ? (const char*)g.A + (size_t)nxt.pm * tstep : cA; const char* nB = has_next ? (const char*)g.Bt + (size_t)nxt.pn * tstep : cB;
        for (int t = 0; t < nt; t += 2) {
            const bool last = (t == nt - 2);
            const char* a1 = cA + (size_t)(t + 1) * kstep;
            const char* a2 = last ? nA : cA + (size_t)(t + 2) * kstep; const char* b2 = last ? nB : cB + (size_t)(t + 2) * kstep;
            const char* a3 = a2 + kstep; const char* b3 = b2 + kstep;
            if (last && has_next) S.a_ready(nxt);
            PG8_LDB(B0, 0, 0); PG8_SCHED; PG8_LDA(At, 0, 0); PG8_STAGE(PG8_SA(1, 1), a1 + hstep, voffA);
            PG8_WAIT_L(8); PG8_BAR; PG8_WAIT_L(0); PG8_MMA(0, 0, At, B0); PG8_BAR; PG8_SCHED;
            PG8_LDB(B1, 0, 1); PG8_STAGE(PG8_SB(0, 0), b2, voffB);
            PG8_BAR; PG8_WAIT_L(0); PG8_MMA(0, 1, At, B1); PG8_BAR;
            PG8_LDA(At, 0, 1); PG8_STAGE(PG8_SA(0, 0), a2, voffA);
            PG8_BAR; PG8_WAIT_L(0); PG8_MMA(1, 0, At, B0); PG8_BAR; PG8_SCHED;
            PG8_STAGE(PG8_SB(0, 1), b2 + hstep, voffB);
            PG8_WAIT_V(6); PG8_BAR; PG8_MMA(1, 1, At, B1); PG8_BAR;
            PG8_LDB(B0, 1, 0); PG8_SCHED; PG8_LDA(At, 1, 0); PG8_STAGE(PG8_SA(0, 1), a2 + hstep, voffA);
            PG8_WAIT_L(8); PG8_BAR; PG8_WAIT_L(0); PG8_MMA(0, 0, At, B0); PG8_BAR; PG8_SCHED;
            PG8_LDB(B1, 1, 1); PG8_STAGE(PG8_SB(1, 0), b3, voffB);
            PG8_BAR; PG8_WAIT_L(0); PG8_MMA(0, 1, At, B1); PG8_BAR;
            PG8_LDA(At, 1, 1); PG8_STAGE(PG8_SA(1, 0), a3, voffA);
            PG8_BAR; PG8_WAIT_L(0); PG8_MMA(1, 0, At, B0); PG8_BAR; PG8_SCHED;
            PG8_STAGE(PG8_SB(1, 1), b3 + hstep, voffB);
            PG8_WAIT_V(6); PG8_BAR; PG8_MMA(1, 1, At, B1); PG8_BAR;
        }
        E(acc, cur, wr, wc, fr, fq, epre); S.done(cur);
        if (!has_next) break;
        E.preload(nxt, wr, fr, epre);
#pragma unroll
        for (int a = 0; a < 2; ++a)
#pragma unroll
            for (int b = 0; b < 2; ++b)
#pragma unroll
                for (int m = 0; m < 4; ++m)
#pragma unroll
                    for (int n = 0; n < 2; ++n) acc[a][b][m][n] = (f32x4){0.f, 0.f, 0.f, 0.f};
        cur = nxt; cA = nA; cB = nB; ++ui;
    }
    PG8_WAIT_V(0);
    if (wr == 0) PG8_BAR;
    PG8_BAR;
#undef PG8_SA
#undef PG8_SB
#undef PG8_STAGE
#undef PG8_LDA
#undef PG8_LDB
#undef PG8_MMA
#undef PG8_WAIT_V
#undef PG8_WAIT_L
#undef PG8_BAR
#undef PG8_SCHED
}
}

using pg8::bf16_t; using pg8::f32x4; using pg8::u32x4; using pg8::u32x2; using pg8::Unit; using pg8::cvt_pk_bf16;

constexpr int DM = 1024, NB = 8, SEQ = 2048, MP = NB * SEQ, DB = 128, DS = 4, MS = DB * DS, MT = MP + MS;
constexpr int MIXA = 512, HEADS = 4, DK = 128, DV = 128, MIXB = 512, CW = 31, DIN = 3072, DFF = 2816, DPLE = 256;
constexpr float EPS = 1e-6f;
static_assert(MT % 256 == 0, "rows");

constexpr size_t O_YP = 0, O_YS = O_YP + (size_t)MP * DM, O_SHP = O_YS + (size_t)MS * DM, O_SCP = O_SHP + (size_t)NB * HEADS * DK * DV,
                 O_SHS = O_SCP + (size_t)NB * (CW - 1) * MIXB, O_SCS = O_SHS + (size_t)DB * HEADS * DK * DV, O_END = O_SCS + (size_t)DB * (CW - 1) * MIXB;

constexpr size_t al256(size_t x) { return (x + 255) & ~(size_t)255; }
constexpr size_t WS_W1 = 0, WS_W2 = WS_W1 + (size_t)DIN * DM * 2, WS_W3 = WS_W2 + (size_t)DM * DM * 2, WS_W4 = WS_W3 + (size_t)2 * DFF * DM * 2,
                 WS_W5 = WS_W4 + (size_t)DM * DFF * 2, WS_W6 = WS_W5 + (size_t)DM * DM * 2, WS_SMALL = WS_W6 + (size_t)DM * DPLE * 2;
constexpr size_t WS_BAR = WS_SMALL, WS_BAR_BYTES = 3456 * 4;
constexpr size_t WS_LB = WS_BAR + WS_BAR_BYTES, WS_SS1 = WS_LB + 4096, WS_SS2 = WS_SS1 + al256((size_t)MT * 4), WS_SS3 = WS_SS2 + al256((size_t)MT * 4), WS_PB = WS_SS3 + al256((size_t)MT * 4);
constexpr size_t WS_C = WS_PB + (size_t)MT * DPLE * 2;
constexpr size_t SZ_H512 = (size_t)MT * 512 * 2;
constexpr size_t WS_Q = WS_C, WS_K = WS_Q + SZ_H512, WS_V = WS_K + SZ_H512, WS_G = WS_V + SZ_H512, WS_U = WS_G + SZ_H512, WS_LOGF = WS_U + SZ_H512, WS_C_END = WS_LOGF + (size_t)MT * 512 * 4;
constexpr size_t WS_HB = WS_C, WS_H3 = WS_HB + (size_t)MT * DM * 2;
static_assert(WS_H3 + (size_t)MT * DM * 2 <= WS_C_END, "overlay");
constexpr size_t WS_D = WS_C_END;
constexpr size_t WS_XN = WS_D, WS_CAT = WS_D, WS_ACT = WS_D, WS_PP = WS_D, WS_END = WS_D + (size_t)MT * DFF * 2;
constexpr int NSEG = 8, SEGL = SEQ / NSEG, NCH = SEGL / 32;
constexpr size_t WS_SLOC = WS_D + (size_t)MT * DM * 2, WS_SDEC = WS_SLOC + (size_t)NB * HEADS * NSEG * DK * DV * 4;
static_assert(WS_SDEC + (size_t)NB * HEADS * NSEG * DK * 4 <= WS_END, "overlay");

struct Params { const float* in[23]; float* out; unsigned char* ws; };
enum { I_XP = 0, I_XS, I_PP, I_PS, I_SH, I_SC, I_NMIX, I_WIN, I_LBL, I_HON, I_CDW, I_CDB, I_CLG, I_CLB, I_WOUT, I_NFFN, I_WG, I_WU, I_WD, I_NPLE, I_WPG, I_WPP, I_NFIN };

__device__ __forceinline__ float bf2f(bf16_t b) { return __uint_as_float(((unsigned)b) << 16); }
__device__ __forceinline__ bf16_t f2bf(float f) { return (bf16_t)(cvt_pk_bf16(f, 0.f) & 0xffffu); }
template <int CTRL> __device__ __forceinline__ float dpp_step(float t) { return t + __builtin_bit_cast(float, __builtin_amdgcn_update_dpp(0, __builtin_bit_cast(int, t), CTRL, 0xF, 0xF, true)); }
__device__ __forceinline__ float wave_sum(float v) {
    float t = dpp_step<0xB1>(v);
    t = dpp_step<0x4E>(t);
    t = dpp_step<0x141>(t);
    t = dpp_step<0x140>(t);
    const int ti = __builtin_bit_cast(int, t);
    return (__builtin_bit_cast(float, __builtin_amdgcn_readlane(ti, 0)) + __builtin_bit_cast(float, __builtin_amdgcn_readlane(ti, 16)))
         + (__builtin_bit_cast(float, __builtin_amdgcn_readlane(ti, 32)) + __builtin_bit_cast(float, __builtin_amdgcn_readlane(ti, 48)));
}
__device__ __forceinline__ float frcp(float x) { return __builtin_amdgcn_rcpf(x); }
__device__ __forceinline__ float sigmoidf_(float x) { return frcp(1.0f + __expf(-x)); }
__device__ __forceinline__ float siluf_(float x) { return x * frcp(1.0f + __expf(-x)); }

#define XB_TMO      128
#define XB_XCNT(j)  (256  + 64 * (j))
#define XB_XSUB(j)  (1280 + 64 * (j))
#define XB_XGEN(j)  (2304 + 64 * (j))
#define XB_TOP      3328
#define XB_TOPGEN   3392
#define XCD_BAR_WORDS 3456
#define XB_SPIN_CAP (1u << 18)
#define XLAS __attribute__((address_space(3)))

__device__ __forceinline__ unsigned xb_ld(unsigned* p)              { return __hip_atomic_load(p, __ATOMIC_RELAXED, __HIP_MEMORY_SCOPE_AGENT); }
__device__ __forceinline__ unsigned xb_add(unsigned* p, unsigned v) { return __hip_atomic_fetch_add(p, v, __ATOMIC_RELAXED, __HIP_MEMORY_SCOPE_AGENT); }
__device__ __forceinline__ unsigned xb_xcc_id() { return (unsigned)__builtin_amdgcn_s_getreg((3 << 11) | 20) & 0xFu; }
#define XB_SPIN(cond, bar) do { unsigned _sp = 0; while (cond) { __builtin_amdgcn_s_sleep(1); \
    if ((++_sp & 255u) == 0u) { if (xb_ld(&(bar)[XB_TMO])) break; if (_sp > XB_SPIN_CAP) { atomicAdd(&(bar)[XB_TMO], 1u); break; } } } } while (0)

struct XcdBarrier {
    unsigned* bar; unsigned x;
    volatile XLAS unsigned* st;
};

__device__ __forceinline__ XcdBarrier xcd_barrier_post(unsigned* bar, volatile XLAS unsigned* st) {
    XcdBarrier b; b.bar = bar; b.x = xb_xcc_id(); b.st = st;
    if (threadIdx.x == 0) (void)xb_add(&bar[XB_XCNT(b.x)], 1u);
    return b;
}
__device__ __forceinline__ void xcd_barrier_complete(unsigned* bar, unsigned x, unsigned& nloc, unsigned& nx) {
    const unsigned G = gridDim.x * gridDim.y * gridDim.z;
    unsigned sum, cnt, mine, sp = 0u;
    for (;;) {
        sum = 0u; cnt = 0u; mine = 0u;
#pragma unroll
        for (unsigned j = 0; j < 16; ++j) { const unsigned c = xb_ld(&bar[XB_XCNT(j)]); sum += c; cnt += (c > 0u) ? 1u : 0u; mine = (j == x) ? c : mine; }
        if (sum == G) break;
        __builtin_amdgcn_s_sleep(1);
        if ((++sp & 255u) == 0u) { if (xb_ld(&bar[XB_TMO])) break; if (sp > XB_SPIN_CAP) { atomicAdd(&bar[XB_TMO], 1u); break; } }
    }
    nloc = mine > 0u ? mine : 1u; nx = cnt > 0u ? cnt : 1u;
}

__device__ __forceinline__ void xcd_barrier(const XcdBarrier& b) {
    asm volatile("s_waitcnt vmcnt(0)" ::: "memory");
    __syncthreads();
    if (threadIdx.x == 0) {
        unsigned* bar = b.bar;
        __builtin_amdgcn_s_waitcnt(0);
        unsigned nloc = b.st[0], nx = b.st[1];
        if (nloc == 0u) { xcd_barrier_complete(bar, b.x, nloc, nx); b.st[0] = nloc; b.st[1] = nx; }
        const unsigned old = xb_add(&bar[XB_XSUB(b.x)], 1u);
        const unsigned gen = old / nloc;
        if (old + 1u == (gen + 1u) * nloc) {
            __builtin_amdgcn_fence(__ATOMIC_RELEASE, "agent");
            asm volatile("s_waitcnt vmcnt(0)" ::: "memory");
            const unsigned og = xb_add(&bar[XB_TOP], 1u);
            const unsigned tg = og / nx;
            if (og + 1u == (tg + 1u) * nx) xb_add(&bar[XB_TOPGEN], 1u);
            else XB_SPIN(xb_ld(&bar[XB_TOPGEN]) == tg, bar);
            __builtin_amdgcn_fence(__ATOMIC_ACQUIRE, "agent");
            xb_add(&bar[XB_XGEN(b.x)], 1u);
            asm volatile("s_waitcnt vmcnt(0)" ::: "memory");
        } else {
            XB_SPIN(xb_ld(&bar[XB_XGEN(b.x)]) == gen, bar);
            __builtin_amdgcn_fence(__ATOMIC_ACQUIRE, "agent");
            asm volatile("s_waitcnt vmcnt(0)" ::: "memory");
        }
    }
    __syncthreads();
}


typedef float f32x16 __attribute__((ext_vector_type(16)));
typedef float f32x2v __attribute__((ext_vector_type(2)));
typedef __bf16 b16x2v __attribute__((ext_vector_type(2)));
typedef short s16x4 __attribute__((ext_vector_type(4)));
using pg8::bf16x8;
__device__ __forceinline__ unsigned pk2(float a, float b) { f32x2v v = {a, b}; b16x2v r = __builtin_convertvector(v, b16x2v); return __builtin_bit_cast(unsigned, r); }
#define HG_MFMA(a, b, c) __builtin_amdgcn_mfma_f32_32x32x16_bf16((a), (b), (c), 0, 0, 0)

#define LDS_BARRIER() do { asm volatile("s_waitcnt lgkmcnt(0)" ::: "memory"); __builtin_amdgcn_s_barrier(); asm volatile("" ::: "memory"); } while (0)

constexpr int SG_P = 36;
template <int K, class Epi>
__device__ __forceinline__ void small_gemm(unsigned char* lds, const bf16_t* A, const bf16_t* Bt, int row0, int br0, int br1, const Epi& E) {
    int tid = threadIdx.x; asm volatile("" : "+v"(tid));
    const int w = __builtin_amdgcn_readfirstlane(tid >> 6), lane = tid & 63, r = lane & 31, hh = lane >> 5;
    constexpr int ks = K >> 3, NS = ks >> 4, UNR = NS <= 8 ? NS : 11; const int k0 = w * ks + 8 * hh;
    const bf16_t* ap = A + (size_t)(row0 + r) * K + k0; const bf16_t* b0p = Bt + (size_t)(br0 + r) * K + k0; const bf16_t* b1p = Bt + (size_t)(br1 + r) * K + k0;
    typename Epi::SPre spre; const int srow = row0 + ((tid >> 3) & 31), sc4 = (tid & 7) * 4;
    if (tid < 256) E.small_pre(srow, br0 + sc4, br1 + sc4, spre);
    f32x16 acc0, acc1;
#pragma unroll
    for (int i = 0; i < 16; ++i) { acc0[i] = 0.f; acc1[i] = 0.f; }
#pragma unroll UNR
    for (int s = 0; s < NS; ++s) { const bf16x8 a = *(const bf16x8*)(ap + 16 * s), b0 = *(const bf16x8*)(b0p + 16 * s), b1 = *(const bf16x8*)(b1p + 16 * s);
        acc0 = HG_MFMA(a, b0, acc0); acc1 = HG_MFMA(a, b1, acc1); }
    float* part = (float*)lds + (size_t)w * (2 * 32 * SG_P);
#pragma unroll
    for (int g = 0; g < 4; ++g)
#pragma unroll
        for (int i = 0; i < 4; ++i) { part[(8 * g + 4 * hh + i) * SG_P + r] = acc0[4 * g + i]; part[(32 + 8 * g + 4 * hh + i) * SG_P + r] = acc1[4 * g + i]; }
    LDS_BARRIER();
    if (tid < 256) { const int row = tid >> 3, c4 = (tid & 7) * 4; f32x4 v0 = {0.f, 0.f, 0.f, 0.f}, v1 = {0.f, 0.f, 0.f, 0.f};
#pragma unroll
        for (int ww = 0; ww < 8; ++ww) { const float* pp = (const float*)lds + (size_t)ww * (2 * 32 * SG_P); v0 += *(const f32x4*)(pp + row * SG_P + c4); v1 += *(const f32x4*)(pp + (32 + row) * SG_P + c4); }
        E.small(row0 + row, br0 + c4, br1 + c4, v0, v1, spre); }
    LDS_BARRIER();
}

__host__ __device__ __forceinline__ int perm12(int s) { return (int)((0xBA5476981032ull >> (4 * s)) & 15ull); }
__host__ __device__ __forceinline__ int permcol(int c) { return perm12(c >> 8) * 256 + (c & 255); }
struct Epi1 {
    static constexpr bool PERM = true;
    bf16_t *Q, *Kk, *V, *G, *U; float* LOGF; const float* LB; float* scp; float* scs;
    static constexpr int NPRE = 1;
    __device__ __forceinline__ void preload(const Unit&, int, int, float (&)[1]) const {}
    __device__ __forceinline__ void operator()(const f32x4 (&acc)[2][2][4][2], const Unit& u, int wr, int wc, int fr, int fq, const float (&epre)[1]) const {
        const int row0 = u.pm * 256 + wr * 64 + fr, pn = perm12(u.pn);
        if (pn < 8) {
            const int type = pn >> 1, cb = (pn & 1) * 256 + wc * 32 + 8 * fq;
            if (type == 1) {
                f32x4 lbv[2][2];
#pragma unroll
                for (int bj = 0; bj < 2; ++bj) { lbv[bj][0] = *(const f32x4*)(LB + cb + bj * 128); lbv[bj][1] = *(const f32x4*)(LB + cb + bj * 128 + 4); }
#pragma unroll
                for (int ai = 0; ai < 2; ++ai)
#pragma unroll
                    for (int m = 0; m < 4; ++m) { const size_t rb = (size_t)(row0 + ai * 128 + m * 16) * 512 + cb;
#pragma unroll
                        for (int bj = 0; bj < 2; ++bj) { f32x4 lg[2], kk[2];
#pragma unroll
                            for (int n = 0; n < 2; ++n)
#pragma unroll
                                for (int j = 0; j < 4; ++j) { const float x = acc[ai][bj][m][n][j]; const float k1 = (1.0f - lbv[bj][n][j]) * frcp(1.0f + __expf(x)); kk[n][j] = k1; lg[n][j] = __log2f(1.0f - k1); }
                            *(f32x4*)(LOGF + rb + bj * 128) = lg[0]; *(f32x4*)(LOGF + rb + bj * 128 + 4) = lg[1];
                            u32x4 w; w.x = cvt_pk_bf16(kk[0][0], kk[0][1]); w.y = cvt_pk_bf16(kk[0][2], kk[0][3]); w.z = cvt_pk_bf16(kk[1][0], kk[1][1]); w.w = cvt_pk_bf16(kk[1][2], kk[1][3]);
                            *(u32x4*)(Kk + rb + bj * 128) = w; } }
            } else {
                bf16_t* dst = Q + (size_t)type * ((size_t)MT * 512);
#pragma unroll
                for (int ai = 0; ai < 2; ++ai)
#pragma unroll
                    for (int m = 0; m < 4; ++m) { const size_t rb = (size_t)(row0 + ai * 128 + m * 16) * 512 + cb;
#pragma unroll
                        for (int bj = 0; bj < 2; ++bj) { f32x4 v0 = acc[ai][bj][m][0], v1 = acc[ai][bj][m][1];
                            if (type != 2) {
#pragma unroll
                                for (int j = 0; j < 4; ++j) { v0[j] = siluf_(v0[j]); v1[j] = siluf_(v1[j]); } }
                            u32x4 w; w.x = cvt_pk_bf16(v0[0], v0[1]); w.y = cvt_pk_bf16(v0[2], v0[3]); w.z = cvt_pk_bf16(v1[0], v1[1]); w.w = cvt_pk_bf16(v1[2], v1[3]);
                            *(u32x4*)(dst + rb + bj * 128) = w; } }
            }
        } else {
            const int cu = (pn - 8) * 128 + wc * 32 + 8 * fq;
#pragma unroll
            for (int ai = 0; ai < 2; ++ai)
#pragma unroll
                for (int m = 0; m < 4; ++m) { const int row = row0 + ai * 128 + m * 16;
                    f32x4 u0, u1;
#pragma unroll
                    for (int j = 0; j < 4; ++j) { u0[j] = acc[ai][0][m][0][j] * sigmoidf_(acc[ai][1][m][0][j]); u1[j] = acc[ai][0][m][1][j] * sigmoidf_(acc[ai][1][m][1][j]); }
                    u32x4 w; w.x = cvt_pk_bf16(u0[0], u0[1]); w.y = cvt_pk_bf16(u0[2], u0[3]); w.z = cvt_pk_bf16(u1[0], u1[1]); w.w = cvt_pk_bf16(u1[2], u1[3]);
                    *(u32x4*)(U + (size_t)row * 512 + cu) = w;
                    if (row < MP) { const int t = row & (SEQ - 1);
                        if (t >= SEQ - (CW - 1)) { float* o = scp + ((size_t)((row >> 11) * (CW - 1) + t - (SEQ - (CW - 1)))) * MIXB + cu; __builtin_nontemporal_store(u0, (f32x4*)o); __builtin_nontemporal_store(u1, (f32x4*)(o + 4)); }
                    } else { const int rs = row - MP; float* o = scs + ((size_t)((rs >> 2) * (CW - 1) + (CW - 1 - DS) + (rs & 3))) * MIXB + cu; *(f32x4*)o = u0; *(f32x4*)(o + 4) = u1; }
                }
        }
    }
    struct SPre { f32x4 l0, l1; };
    __device__ __forceinline__ void small_pre(int row, int c0p, int c1p, SPre& sp) const { const int c0 = permcol(c0p), c1 = permcol(c1p);
        if ((c0 >> 9) == 1) { sp.l0 = *(const f32x4*)(LB + (c0 & 511)); sp.l1 = *(const f32x4*)(LB + (c1 & 511)); } else { sp.l0 = (f32x4){0.f, 0.f, 0.f, 0.f}; sp.l1 = sp.l0; } }
    __device__ __forceinline__ void small(int row, int c0p, int c1p, const f32x4& v0, const f32x4& v1, const SPre& sp) const {
        const int c0 = permcol(c0p), c1 = permcol(c1p);
        if (c0 < 2048) { const int type = c0 >> 9;
#pragma unroll
            for (int gsel = 0; gsel < 2; ++gsel) { const int cs = (gsel ? c1 : c0) & 511; const f32x4 x = gsel ? v1 : v0; const size_t rb = (size_t)row * 512 + cs;
                if (type == 1) { const f32x4 lb = gsel ? sp.l1 : sp.l0; f32x4 lg; float kk[4];
#pragma unroll
                    for (int j = 0; j < 4; ++j) { kk[j] = (1.0f - lb[j]) * frcp(1.0f + __expf(x[j])); lg[j] = __log2f(1.0f - kk[j]); }
                    *(f32x4*)(LOGF + rb) = lg; u32x2 w; w.x = cvt_pk_bf16(kk[0], kk[1]); w.y = cvt_pk_bf16(kk[2], kk[3]); *(u32x2*)(Kk + rb) = w;
                } else { bf16_t* dst = Q + (size_t)type * ((size_t)MT * 512); f32x4 y = x;
                    if (type != 2) {
#pragma unroll
                        for (int j = 0; j < 4; ++j) y[j] = siluf_(y[j]); }
                    u32x2 w; w.x = cvt_pk_bf16(y[0], y[1]); w.y = cvt_pk_bf16(y[2], y[3]); *(u32x2*)(dst + rb) = w; } }
        } else { const int n1 = c0 - 2048, cu = (n1 >> 8) * 128 + (n1 & 127); f32x4 uu;
#pragma unroll
            for (int j = 0; j < 4; ++j) uu[j] = v0[j] * sigmoidf_(v1[j]);
            u32x2 w; w.x = cvt_pk_bf16(uu[0], uu[1]); w.y = cvt_pk_bf16(uu[2], uu[3]); *(u32x2*)(U + (size_t)row * 512 + cu) = w;
            const int rs = row - MP; __builtin_nontemporal_store(uu, (f32x4*)(scs + ((size_t)((rs >> 2) * (CW - 1) + (CW - 1 - DS) + (rs & 3))) * MIXB + cu)); }
    }
};
__device__ __forceinline__ void unpack8(const u32x4& w, f32x4& a, f32x4& b) {
    a[0] = __uint_as_float(w.x << 16); a[1] = __uint_as_float(w.x & 0xffff0000u); a[2] = __uint_as_float(w.y << 16); a[3] = __uint_as_float(w.y & 0xffff0000u);
    b[0] = __uint_as_float(w.z << 16); b[1] = __uint_as_float(w.z & 0xffff0000u); b[2] = __uint_as_float(w.w << 16); b[3] = __uint_as_float(w.w & 0xffff0000u); }
__device__ __forceinline__ f32x4 unpack4(const u32x2& w) { f32x4 a; a[0] = __uint_as_float(w.x << 16); a[1] = __uint_as_float(w.x & 0xffff0000u); a[2] = __uint_as_float(w.y << 16); a[3] = __uint_as_float(w.y & 0xffff0000u); return a; }
template <bool BASEBF>
struct EpiRes {
    static constexpr bool PERM = true;
    const float* base0; const float* base1; bf16_t* HB; float* sumsq; bf16_t* HBo;
    static constexpr int NPRE = 1;
    __device__ __forceinline__ void preload(const Unit&, int, int, float (&)[1]) const {}
    __device__ __forceinline__ void operator()(const f32x4 (&acc)[2][2][4][2], const Unit& u, int wr, int wc, int fr, int fq, const float (&epre)[1]) const {
        const int row0 = u.pm * 256 + wr * 64 + fr, col0 = u.pn * 256 + wc * 32 + 8 * fq;
#pragma unroll
        for (int ai = 0; ai < 2; ++ai) {
            float ssv[4];
            f32x4 bv[4][2][2];
#pragma unroll
            for (int m = 0; m < 4; ++m) { const int row = row0 + ai * 128 + m * 16;
#pragma unroll
                for (int bj = 0; bj < 2; ++bj) {
                    if (BASEBF) { unpack8(*(const u32x4*)(HB + (size_t)row * DM + col0 + bj * 128), bv[m][bj][0], bv[m][bj][1]); }
                    else { const float* bp = (row < MP ? base0 + (size_t)row * DM : base1 + (size_t)(row - MP) * DM) + col0 + bj * 128; bv[m][bj][0] = __builtin_nontemporal_load((const f32x4*)bp); bv[m][bj][1] = __builtin_nontemporal_load((const f32x4*)(bp + 4)); } } }
#pragma unroll
            for (int m = 0; m < 4; ++m) { const int row = row0 + ai * 128 + m * 16;
                float ss = 0.f;
#pragma unroll
                for (int bj = 0; bj < 2; ++bj) { const f32x4 h0 = bv[m][bj][0] + acc[ai][bj][m][0], h1 = bv[m][bj][1] + acc[ai][bj][m][1];
                    u32x4 w; w.x = cvt_pk_bf16(h0[0], h0[1]); w.y = cvt_pk_bf16(h0[2], h0[3]); w.z = cvt_pk_bf16(h1[0], h1[1]); w.w = cvt_pk_bf16(h1[2], h1[3]);
                    *(u32x4*)(HBo + (size_t)row * DM + col0 + bj * 128) = w;
                    ss += (h0[0] * h0[0] + h0[1] * h0[1]) + (h0[2] * h0[2] + h0[3] * h0[3]) + (h1[0] * h1[0] + h1[1] * h1[1]) + (h1[2] * h1[2] + h1[3] * h1[3]); }
                ssv[m] = ss;
            }
#pragma unroll
            for (int m = 0; m < 4; ++m) ssv[m] += __shfl_xor(ssv[m], 16);
#pragma unroll
            for (int m = 0; m < 4; ++m) ssv[m] += __shfl_xor(ssv[m], 32);
            if (fq == 0) {
#pragma unroll
                for (int m = 0; m < 4; ++m) atomicAdd(sumsq + row0 + ai * 128 + m * 16, ssv[m]); }
        }
    }
    struct SPre { f32x4 b0, b1; };
    __device__ __forceinline__ void small_pre(int row, int c0, int c1, SPre& sp) const {
        if (BASEBF) { sp.b0 = unpack4(*(const u32x2*)(HB + (size_t)row * DM + c0)); sp.b1 = unpack4(*(const u32x2*)(HB + (size_t)row * DM + c1)); }
        else { const float* bp = row < MP ? base0 + (size_t)row * DM : base1 + (size_t)(row - MP) * DM; sp.b0 = *(const f32x4*)(bp + c0); sp.b1 = *(const f32x4*)(bp + c1); } }
    __device__ __forceinline__ void small(int row, int c0, int c1, const f32x4& v0, const f32x4& v1, const SPre& sp) const {
        float ss = 0.f;
#pragma unroll
        for (int gsel = 0; gsel < 2; ++gsel) { const int c = gsel ? c1 : c0; bf16_t* hb = HB + (size_t)row * DM + c; f32x4 h;
            h = gsel ? sp.b1 : sp.b0;
            h += (gsel ? v1 : v0);
            u32x2 w; w.x = cvt_pk_bf16(h[0], h[1]); w.y = cvt_pk_bf16(h[2], h[3]); *(u32x2*)(HBo + (size_t)row * DM + c) = w;
            ss += (h[0] * h[0] + h[1] * h[1]) + (h[2] * h[2] + h[3] * h[3]); }
        ss = dpp_step<0x141>(dpp_step<0x4E>(dpp_step<0xB1>(ss)));
        if ((threadIdx.x & 7) == 0) atomicAdd(sumsq + row, ss);
    }
};
struct EpiSwi {
    static constexpr bool PERM = true;
    const float* sumsq; bf16_t* ACT;
    static constexpr int NPRE = 8;
    __device__ __forceinline__ void preload(const Unit& u, int wr, int fr, float (&pre)[8]) const { const int row0 = u.pm * 256 + wr * 64 + fr;
#pragma unroll
        for (int ai = 0; ai < 2; ++ai)
#pragma unroll
            for (int m = 0; m < 4; ++m) pre[ai * 4 + m] = sumsq[row0 + ai * 128 + m * 16]; }
    __device__ __forceinline__ void operator()(const f32x4 (&acc)[2][2][4][2], const Unit& u, int wr, int wc, int fr, int fq, const float (&epre)[8]) const {
        const int row0 = u.pm * 256 + wr * 64 + fr, col0 = u.pn * 128 + wc * 32 + 8 * fq;
#pragma unroll
        for (int ai = 0; ai < 2; ++ai)
#pragma unroll
            for (int m = 0; m < 4; ++m) { const int row = row0 + ai * 128 + m * 16;
                const float rstd = rsqrtf(epre[ai * 4 + m] * (1.0f / DM) + EPS), c1 = -1.44269504f * rstd, c2 = rstd * rstd;
                f32x4 av[2];
#pragma unroll
                for (int n = 0; n < 2; ++n) { const f32x4 g = acc[ai][0][m][n], t = g * c1; f32x4 e;
#pragma unroll
                    for (int j = 0; j < 4; ++j) e[j] = __builtin_amdgcn_exp2f(t[j]);
                    const f32x4 d = e + 1.0f; f32x4 r;
#pragma unroll
                    for (int j = 0; j < 4; ++j) r[j] = frcp(d[j]);
                    av[n] = (g * acc[ai][1][m][n]) * (r * c2); }
                u32x4 w; w.x = cvt_pk_bf16(av[0][0], av[0][1]); w.y = cvt_pk_bf16(av[0][2], av[0][3]); w.z = cvt_pk_bf16(av[1][0], av[1][1]); w.w = cvt_pk_bf16(av[1][2], av[1][3]);
                __builtin_nontemporal_store(w, (u32x4*)(ACT + (size_t)row * DFF + col0)); }
    }
};
struct EpiBf {
    static constexpr bool PERM = true;
    bf16_t* O;
    static constexpr int NPRE = 1;
    __device__ __forceinline__ void preload(const Unit&, int, int, float (&)[1]) const {}
    __device__ __forceinline__ void operator()(const f32x4 (&acc)[2][2][4][2], const Unit& u, int wr, int wc, int fr, int fq, const float (&epre)[1]) const {
        const int row0 = u.pm * 256 + wr * 64 + fr, col0 = u.pn * 256 + wc * 32 + 8 * fq;
#pragma unroll
        for (int ai = 0; ai < 2; ++ai)
#pragma unroll
            for (int m = 0; m < 4; ++m)
#pragma unroll
                for (int bj = 0; bj < 2; ++bj) { const f32x4 v0 = acc[ai][bj][m][0], v1 = acc[ai][bj][m][1];
                    u32x4 w; w.x = cvt_pk_bf16(v0[0], v0[1]); w.y = cvt_pk_bf16(v0[2], v0[3]); w.z = cvt_pk_bf16(v1[0], v1[1]); w.w = cvt_pk_bf16(v1[2], v1[3]);
                    *(u32x4*)(O + (size_t)(row0 + ai * 128 + m * 16) * DM + col0 + bj * 128) = w; }
    }
    struct SPre { int dummy; };
    __device__ __forceinline__ void small_pre(int, int, int, SPre& sp) const { sp.dummy = 0; }
    __device__ __forceinline__ void small(int row, int c0, int c1, const f32x4& v0, const f32x4& v1, const SPre& sp) const {
        u32x2 w; w.x = cvt_pk_bf16(v0[0], v0[1]); w.y = cvt_pk_bf16(v0[2], v0[3]); *(u32x2*)(O + (size_t)row * DM + c0) = w;
        w.x = cvt_pk_bf16(v1[0], v1[1]); w.y = cvt_pk_bf16(v1[2], v1[3]); *(u32x2*)(O + (size_t)row * DM + c1) = w;
    }
};
struct EpiPle {
    static constexpr bool PERM = true;
    const float* sumsq2; const bf16_t* PPb; const bf16_t* HB; bf16_t* H3; float* sumsq3;
    static constexpr int NPRE = 8;
    __device__ __forceinline__ void preload(const Unit& u, int wr, int fr, float (&pre)[8]) const { const int row0 = u.pm * 256 + wr * 64 + fr;
#pragma unroll
        for (int ai = 0; ai < 2; ++ai)
#pragma unroll
            for (int m = 0; m < 4; ++m) pre[ai * 4 + m] = sumsq2[row0 + ai * 128 + m * 16]; }
    __device__ __forceinline__ void operator()(const f32x4 (&acc)[2][2][4][2], const Unit& u, int wr, int wc, int fr, int fq, const float (&epre)[8]) const {
        const int row0 = u.pm * 256 + wr * 64 + fr, col0 = u.pn * 256 + wc * 32 + 8 * fq;
#pragma unroll
        for (int ai = 0; ai < 2; ++ai) {
            float ssv[4];
            u32x4 hw[4][2], pw[4][2];
#pragma unroll
            for (int m = 0; m < 4; ++m)
#pragma unroll
                for (int bj = 0; bj < 2; ++bj) { const size_t o = (size_t)(row0 + ai * 128 + m * 16) * DM + col0 + bj * 128; hw[m][bj] = *(const u32x4*)(HB + o); pw[m][bj] = *(const u32x4*)(PPb + o); }
#pragma unroll
            for (int m = 0; m < 4; ++m) { const int row = row0 + ai * 128 + m * 16;
                const float rstd = rsqrtf(epre[ai * 4 + m] * (1.0f / DM) + EPS);
                float ss = 0.f;
#pragma unroll
                for (int bj = 0; bj < 2; ++bj) { const size_t o = (size_t)row * DM + col0 + bj * 128;
                    f32x4 h0, h1, p0, p1; unpack8(hw[m][bj], h0, h1); unpack8(pw[m][bj], p0, p1);
#pragma unroll
                    for (int j = 0; j < 4; ++j) { h0[j] += sigmoidf_(acc[ai][bj][m][0][j] * rstd) * p0[j]; h1[j] += sigmoidf_(acc[ai][bj][m][1][j] * rstd) * p1[j]; }
                    u32x4 w; w.x = cvt_pk_bf16(h0[0], h0[1]); w.y = cvt_pk_bf16(h0[2], h0[3]); w.z = cvt_pk_bf16(h1[0], h1[1]); w.w = cvt_pk_bf16(h1[2], h1[3]);
                    *(u32x4*)(H3 + o) = w;
                    ss += (h0[0] * h0[0] + h0[1] * h0[1]) + (h0[2] * h0[2] + h0[3] * h0[3]) + (h1[0] * h1[0] + h1[1] * h1[1]) + (h1[2] * h1[2] + h1[3] * h1[3]); }
                ssv[m] = ss;
            }
#pragma unroll
            for (int m = 0; m < 4; ++m) ssv[m] += __shfl_xor(ssv[m], 16);
#pragma unroll
            for (int m = 0; m < 4; ++m) ssv[m] += __shfl_xor(ssv[m], 32);
            if (fq == 0) {
#pragma unroll
                for (int m = 0; m < 4; ++m) atomicAdd(sumsq3 + row0 + ai * 128 + m * 16, ssv[m]); }
        }
    }
    struct SPre { f32x4 h0, h1; float ss; };
    __device__ __forceinline__ void small_pre(int row, int c0, int c1, SPre& sp) const { sp.ss = sumsq2[row]; sp.h0 = unpack4(*(const u32x2*)(HB + (size_t)row * DM + c0)); sp.h1 = unpack4(*(const u32x2*)(HB + (size_t)row * DM + c1)); }
    __device__ __forceinline__ void small(int row, int c0, int c1, const f32x4& v0, const f32x4& v1, const SPre& sp) const {
        const float rstd = rsqrtf(sp.ss * (1.0f / DM) + EPS); float ss = 0.f;
#pragma unroll
        for (int gsel = 0; gsel < 2; ++gsel) { const int c = gsel ? c1 : c0; const f32x4 x = gsel ? v1 : v0; const size_t o = (size_t)row * DM + c;
            f32x4 h = gsel ? sp.h1 : sp.h0; const f32x4 pp = unpack4(*(const u32x2*)(PPb + o));
#pragma unroll
            for (int j = 0; j < 4; ++j) h[j] += sigmoidf_(x[j] * rstd) * pp[j];
            u32x2 w; w.x = cvt_pk_bf16(h[0], h[1]); w.y = cvt_pk_bf16(h[2], h[3]); *(u32x2*)(H3 + o) = w;
            ss += (h[0] * h[0] + h[1] * h[1]) + (h[2] * h[2] + h[3] * h[3]); }
        ss = dpp_step<0x141>(dpp_step<0x4E>(dpp_step<0xB1>(ss)));
        if ((threadIdx.x & 7) == 0) atomicAdd(sumsq3 + row, ss);
    }
};

struct OrderFfn {
    pg8::StaticOrder so; int nsamp, nN;
    __device__ void init(int G, int c) { so.init(MP, 2 * DFF, G, c); nN = 2 * DFF / 256; nsamp = (MS / 256) * nN; }
    __device__ bool next(int i, Unit& u) const { const long L = (long)i * so.G + so.c;
        if (L < so.nwg) return so.next(i, u);
        const int e = (int)(L - so.nwg); if (e >= nsamp) return false; u.pm = MP / 256 + e / nN; u.pn = e % nN; return true; }
    __device__ __forceinline__ void a_ready(const Unit&) const {}
    __device__ __forceinline__ void done(const Unit&) const {}
};

struct TrItem { const float* W; const float* gain; bf16_t* WT; int ldw, K, sc0, dr0, kb; };
__device__ __forceinline__ void tr_decode(const Params& p, int r, TrItem& t) {
    constexpr int I1 = (DM / 64) * (DIN / 32), I2 = (DM / 64) * (DM / 32), I3 = (DM / 64) * (2 * DFF / 32), I4 = (DFF / 64) * (DM / 32), I5 = I2;
    unsigned char* ws = p.ws; t.gain = nullptr;
    if (r < I1) { const int nb = r % (DIN / 32), n0p = nb * 32, n0 = permcol(n0p); t.kb = r / (DIN / 32);
        if (n0 < 2048) t.sc0 = n0; else { const int n1 = n0 - 2048, tt = n1 >> 8, w = n1 & 255; t.sc0 = 2048 + (w >> 7) * 512 + tt * 128 + (w & 127); }
        t.W = p.in[I_WIN]; t.ldw = DIN; t.K = DM; t.WT = (bf16_t*)(ws + WS_W1); t.dr0 = n0p; return; } r -= I1;
    if (r < I2) { const int nb = r % (DM / 32); t.kb = r / (DM / 32); t.W = p.in[I_WOUT]; t.ldw = DM; t.K = DM; t.sc0 = nb * 32; t.WT = (bf16_t*)(ws + WS_W2); t.dr0 = nb * 32; return; } r -= I2;
    if (r < I3) { const int nb = r % (2 * DFF / 32), n0 = nb * 32, tt = n0 >> 8, w = n0 & 255; t.kb = r / (2 * DFF / 32);
        t.W = (w >> 7) ? p.in[I_WU] : p.in[I_WG]; t.ldw = DFF; t.K = DM; t.sc0 = tt * 128 + (w & 127); t.gain = p.in[I_NFFN]; t.WT = (bf16_t*)(ws + WS_W3); t.dr0 = n0; return; } r -= I3;
    if (r < I4) { const int nb = r % (DM / 32); t.kb = r / (DM / 32); t.W = p.in[I_WD]; t.ldw = DM; t.K = DFF; t.sc0 = nb * 32; t.WT = (bf16_t*)(ws + WS_W4); t.dr0 = nb * 32; return; } r -= I4;
    if (r < I5) { const int nb = r % (DM / 32); t.kb = r / (DM / 32); t.W = p.in[I_WPG]; t.ldw = DM; t.K = DM; t.sc0 = nb * 32; t.gain = p.in[I_NPLE]; t.WT = (bf16_t*)(ws + WS_W5); t.dr0 = nb * 32; return; } r -= I5;
    { const int nb = r % (DM / 32); t.kb = r / (DM / 32); t.W = p.in[I_WPP]; t.ldw = DM; t.K = DPLE; t.sc0 = nb * 32; t.WT = (bf16_t*)(ws + WS_W6); t.dr0 = nb * 32; }
}
__device__ __forceinline__ void tr_load(const TrItem& t, int lane, f32x4 (&v)[8], f32x4 (&g)[2]) {
    const int r = lane & 7, k0 = 64 * t.kb + 8 * (lane >> 3); const float* src = t.W + (size_t)k0 * t.ldw + t.sc0 + 4 * r;
#pragma unroll
    for (int i = 0; i < 8; ++i) v[i] = __builtin_nontemporal_load((const f32x4*)(src + (size_t)i * t.ldw));
    if (t.gain) { g[0] = *(const f32x4*)(t.gain + k0); g[1] = *(const f32x4*)(t.gain + k0 + 4); } else { g[0] = (f32x4){1.f, 1.f, 1.f, 1.f}; g[1] = g[0]; }
}
__device__ __forceinline__ void tr_store(const TrItem& t, int lane, const f32x4 (&v)[8], const f32x4 (&g)[2]) {
    const int r = lane & 7, k0 = 64 * t.kb + 8 * (lane >> 3); bf16_t* dst = t.WT + (size_t)(t.dr0 + 4 * r) * t.K + k0;
#pragma unroll
    for (int j = 0; j < 4; ++j) { u32x4 o; o.x = cvt_pk_bf16(v[0][j] * g[0][0], v[1][j] * g[0][1]); o.y = cvt_pk_bf16(v[2][j] * g[0][2], v[3][j] * g[0][3]);
        o.z = cvt_pk_bf16(v[4][j] * g[1][0], v[5][j] * g[1][1]); o.w = cvt_pk_bf16(v[6][j] * g[1][2], v[7][j] * g[1][3]); *(u32x4*)(dst + (size_t)j * t.K) = o; }
}

__device__ __forceinline__ void p0_prologue(const Params& p, unsigned char* lds) {
    const int tid = threadIdx.x, lane = tid & 63, wave = tid >> 6, G = gridDim.x;
    const int gw = blockIdx.x * 8 + wave, NGW = G * 8;
    unsigned char* ws = p.ws;
    constexpr int NITEMS = (DM / 64) * (DIN / 32) + 2 * (DM / 64) * (DM / 32) + (DM / 64) * (2 * DFF / 32) + (DFF / 64) * (DM / 32) + (DPLE / 64) * (DM / 32);
    for (int it = 2 * gw; it < NITEMS; it += 2 * NGW) {
        const int it1 = it + 1 < NITEMS ? it + 1 : it;
        TrItem t0, t1; tr_decode(p, it, t0); tr_decode(p, it1, t1);
        f32x4 v0[8], v1[8], g0[2], g1[2];
        tr_load(t0, lane, v0, g0); tr_load(t1, lane, v1, g1);
        tr_store(t0, lane, v0, g0); tr_store(t1, lane, v1, g1);
    }
    {
        const f32x4* gp = (const f32x4*)p.in[I_NMIX] + lane; f32x4 gv[4];
#pragma unroll
        for (int j = 0; j < 4; ++j) gv[j] = gp[64 * j];
        bf16_t* XN = (bf16_t*)(ws + WS_XN);
        for (int m0 = 4 * gw; m0 < MT; m0 += 4 * NGW) {
            int mm[4]; const float* xr[4];
#pragma unroll
            for (int q = 0; q < 4; ++q) { mm[q] = m0 + q;
                xr[q] = mm[q] < MP ? p.in[I_XP] + (size_t)mm[q] * DM : p.in[I_XS] + (size_t)(mm[q] - MP) * DM; }
            f32x4 v[4][4];
#pragma unroll
            for (int q = 0; q < 4; ++q)
#pragma unroll
                for (int j = 0; j < 4; ++j) v[q][j] = __builtin_nontemporal_load((const f32x4*)xr[q] + lane + 64 * j);
#pragma unroll
            for (int q = 0; q < 4; ++q) { float s = 0.f;
#pragma unroll
                for (int j = 0; j < 4; ++j) s += (v[q][j][0] * v[q][j][0] + v[q][j][1] * v[q][j][1]) + (v[q][j][2] * v[q][j][2] + v[q][j][3] * v[q][j][3]);
                const float rstd = rsqrtf(wave_sum(s) * (1.0f / DM) + EPS);
                u32x2* o8 = (u32x2*)(XN + (size_t)mm[q] * DM) + lane;
#pragma unroll
                for (int j = 0; j < 4; ++j) { u32x2 o; o.x = cvt_pk_bf16(v[q][j][0] * rstd * gv[j][0], v[q][j][1] * rstd * gv[j][1]); o.y = cvt_pk_bf16(v[q][j][2] * rstd * gv[j][2], v[q][j][3] * rstd * gv[j][3]); o8[64 * j] = o; } }
        }
    }
    const size_t gt = (size_t)blockIdx.x * 512 + tid, NT = (size_t)G * 512;
    { bf16_t* PB = (bf16_t*)(ws + WS_PB); constexpr size_t NPB = (size_t)MT * DPLE / 8;
      for (size_t i0 = gt; i0 < NPB; i0 += 4 * NT) { f32x4 a[4], b[4]; size_t e[4];
#pragma unroll
          for (int q = 0; q < 4; ++q) { const size_t i = i0 + q * NT < NPB ? i0 + q * NT : i0; e[q] = i * 8; const float* s = e[q] < (size_t)MP * DPLE ? p.in[I_PP] + e[q] : p.in[I_PS] + (e[q] - (size_t)MP * DPLE);
              a[q] = __builtin_nontemporal_load((const f32x4*)s); b[q] = __builtin_nontemporal_load((const f32x4*)(s + 4)); }
#pragma unroll
          for (int q = 0; q < 4; ++q) { u32x4 w; w.x = cvt_pk_bf16(a[q][0], a[q][1]); w.y = cvt_pk_bf16(a[q][2], a[q][3]); w.z = cvt_pk_bf16(b[q][0], b[q][1]); w.w = cvt_pk_bf16(b[q][2], b[q][3]); *(u32x4*)(PB + e[q]) = w; } } }
    { float* z = (float*)(ws + WS_SS1); for (size_t i = gt; i < (WS_PB - WS_SS1) / 4; i += NT) z[i] = 0.f; }
    if (gt < MIXA) { const float l0 = p.in[I_LBL][gt], l1 = p.in[I_LBL][MIXA + gt]; ((float*)(ws + WS_LB))[gt] = 1.0f / (1.0f + expf(l1 - l0)); }
    { float* scs = p.out + O_SCS; const float* sc = p.in[I_SC]; constexpr int RW = (CW - 1 - DS) * MIXB / 4; constexpr size_t NCP = (size_t)DB * RW;
      for (size_t i0 = gt; i0 < NCP; i0 += 4 * NT) { f32x4 v[4]; size_t d[4];
#pragma unroll
          for (int q = 0; q < 4; ++q) { const size_t i = i0 + q * NT < NCP ? i0 + q * NT : i0, n = i / RW, w = i % RW; d[q] = n * (CW - 1) * MIXB + w * 4; v[q] = __builtin_nontemporal_load((const f32x4*)(sc + d[q] + DS * MIXB)); }
#pragma unroll
          for (int q = 0; q < 4; ++q) __builtin_nontemporal_store(v[q], (f32x4*)(scs + d[q])); } }
}

__device__ __forceinline__ void hgrn_sample_pair(const Params& p, float* lds, int unit) {
    int tid = threadIdx.x; asm volatile("" : "+v"(tid));
    const int half = tid >> 8, v = tid & 127, kg = (tid >> 7) & 1, lane = tid & 63, wq = (tid >> 6) & 3;
    unsigned char* ws = p.ws;
    const bf16_t* Q = (const bf16_t*)(ws + WS_Q); const bf16_t* Kk = (const bf16_t*)(ws + WS_K); const bf16_t* V = (const bf16_t*)(ws + WS_V); const bf16_t* Gt = (const bf16_t*)(ws + WS_G);
    const float* LOGF = (const float*)(ws + WS_LOGF); bf16_t* CAT = (bf16_t*)(ws + WS_CAT);
    const int n = unit >> 2, h = unit & 3, rowbase = MP + n * DS;
    float* sq = lds + half * 3072; float* sk = sq + 512; float* sf = sq + 1024; float* sv = sq + 1536; float* po = sq + 2048;
    float S[64]; float gn0 = 0.f, gn1 = 0.f, gt0 = 0.f, gt1 = 0.f;
    if (unit >= 0) {
        { const size_t g = (size_t)(rowbase + wq) * 512 + h * 128; gn0 = p.in[I_HON][lane]; gn1 = p.in[I_HON][lane + 64]; gt0 = bf2f(Gt[g + lane]); gt1 = bf2f(Gt[g + lane + 64]); }
        const float* s0 = p.in[I_SH] + ((size_t)(n * HEADS + h) * DK) * DV + (size_t)(64 * kg) * DV + v;
#pragma unroll
        for (int k = 0; k < 64; ++k) S[k] = __builtin_nontemporal_load(s0 + (size_t)k * DV);
#pragma unroll
        for (int i = 0; i < 2; ++i) { const int idx = (tid & 255) + 256 * i, t = idx >> 7, c = idx & 127; const size_t g = (size_t)(rowbase + t) * 512 + h * 128 + c;
            sq[idx] = bf2f(Q[g]); sk[idx] = bf2f(Kk[g]); sf[idx] = __builtin_amdgcn_exp2f(LOGF[g]); sv[idx] = bf2f(V[g]); }
    }
    LDS_BARRIER();
    if (unit >= 0) {
#pragma unroll
        for (int t = 0; t < DS; ++t) { const float vt = sv[t * 128 + v]; float o = 0.f; const float* f_ = sf + t * 128 + 64 * kg; const float* k_ = sk + t * 128 + 64 * kg; const float* q_ = sq + t * 128 + 64 * kg;
#pragma unroll
            for (int k = 0; k < 64; ++k) { S[k] = f_[k] * S[k] + k_[k] * vt; o += q_[k] * S[k]; }
            po[(t * 2 + kg) * 128 + v] = o; }
        float* so = p.out + O_SHS + ((size_t)(n * HEADS + h) * DK) * DV + (size_t)(64 * kg) * DV + v;
#pragma unroll
        for (int k = 0; k < 64; ++k) __builtin_nontemporal_store(S[k], so + (size_t)k * DV);
    }
    LDS_BARRIER();
    if (unit >= 0) { const int t = wq; const float* pp = po + (t * 2) * 128;
        const float a = pp[lane] + pp[128 + lane], b = pp[lane + 64] + pp[128 + lane + 64];
        const float rstd = rsqrtf(wave_sum(a * a + b * b) * (1.0f / DV) + EPS); const int row = rowbase + t; const size_t g = (size_t)row * 512 + h * 128;
        CAT[(size_t)row * DM + h * 128 + lane] = f2bf(a * rstd * gn0 * gt0); CAT[(size_t)row * DM + h * 128 + lane + 64] = f2bf(b * rstd * gn1 * gt1); }
    LDS_BARRIER();
}

__device__ __forceinline__ bf16x8 pack8(const f32x16& x, int s) {
    u32x4 q; q.x = pk2(x[8 * s], x[8 * s + 1]); q.y = pk2(x[8 * s + 2], x[8 * s + 3]); q.z = pk2(x[8 * s + 4], x[8 * s + 5]); q.w = pk2(x[8 * s + 6], x[8 * s + 7]); return __builtin_bit_cast(bf16x8, q); }
constexpr int QP = 136, TP = 40;
constexpr int HB_QD = 0, HB_KI = 32 * QP * 2, HB_KD = 2 * HB_KI, HB_VT = HB_KD + 128 * TP * 2, HB_DV = HB_VT + 128 * TP * 2, HB_SZ = HB_DV + 512, H_P = 2 * HB_SZ;
constexpr int H_PSZ = 2 * 32 * 128 * 4, LDS_MAIN = (H_P + 2 * H_PSZ) > pg8::STAGE_BYTES ? (H_P + 2 * H_PSZ) : pg8::STAGE_BYTES;

template <bool FULL>
__device__ __forceinline__ void hgrn_seg(const Params& p, unsigned char* lds, int b, int h, int seg) {
    const int tid = threadIdx.x, lane = tid & 63, w = __builtin_amdgcn_readfirstlane(tid >> 6);
    const int pk = 16 * w + (lane & 15), tg = lane >> 4;
    const int vb = w & 3, kh = w >> 2, r = lane & 31, hh = lane >> 5;
    unsigned char* ws = p.ws;
    const bf16_t* Q = (const bf16_t*)(ws + WS_Q); const bf16_t* Kk = (const bf16_t*)(ws + WS_K); const bf16_t* V = (const bf16_t*)(ws + WS_V); const bf16_t* Gt = (const bf16_t*)(ws + WS_G);
    const float* LOGF = (const float*)(ws + WS_LOGF); bf16_t* CAT = (bf16_t*)(ws + WS_CAT);
    float* SLOC = (float*)(ws + WS_SLOC); float* SDEC = (float*)(ws + WS_SDEC);
    const int row0 = b * SEQ + seg * SEGL, bh = b * HEADS + h;
    f32x16 S[2];
#pragma unroll
    for (int a = 0; a < 2; ++a)
#pragma unroll
        for (int i = 0; i < 16; ++i) S[a][i] = 0.f;
    if (FULL && seg > 0) {
        float* dl = (float*)(lds + H_P);
        for (int idx = tid; idx < seg * DK; idx += 512) dl[idx] = SDEC[(size_t)bh * NSEG * DK + idx];
        LDS_BARRIER();
        const float* sl0 = SLOC + (size_t)bh * NSEG * DK * DV + (size_t)(w * 8 * 64 + lane) * 4;
#pragma unroll 2
        for (int j = 0; j < seg; ++j) { const float* sl = sl0 + (size_t)j * DK * DV; const float* dj = dl + j * DK + 64 * kh + 4 * hh;
#pragma unroll
            for (int a = 0; a < 2; ++a)
#pragma unroll
                for (int g = 0; g < 4; ++g) { const f32x4 d4 = *(const f32x4*)(dj + 32 * a + 8 * g), s4 = *(const f32x4*)(sl + (a * 4 + g) * 256);
#pragma unroll
                    for (int i = 0; i < 4; ++i) S[a][4 * g + i] = d4[i] * S[a][4 * g + i] + s4[i]; } }
        LDS_BARRIER();
    }
    float bseg = 0.f;
    float lf[8]; unsigned kq[8], qq[8], vv[8], gq[8];
    const float gn0 = p.in[I_HON][lane], gn1 = p.in[I_HON][lane + 64];
#define HG_LOAD(c) do { const size_t g0 = (size_t)(row0 + (c) * 32 + 8 * tg) * 512 + h * 128 + pk; \
        _Pragma("unroll") for (int i = 0; i < 8; ++i) { lf[i] = LOGF[g0 + (size_t)i * 512]; kq[i] = Kk[g0 + (size_t)i * 512]; vv[i] = V[g0 + (size_t)i * 512]; if (FULL) qq[i] = Q[g0 + (size_t)i * 512]; } \
        if (FULL) { _Pragma("unroll") for (int tt = 0; tt < 4; ++tt) { const size_t g1 = (size_t)(row0 + (c) * 32 + 4 * w + tt) * 512 + h * 128; gq[2 * tt] = Gt[g1 + lane]; gq[2 * tt + 1] = Gt[g1 + lane + 64]; } } } while (0)
    float gprev[8];
#pragma unroll
    for (int i = 0; i < 8; ++i) gprev[i] = 0.f;
#define HG_FINALIZE(cc) do { const float* P0 = (const float*)(lds + H_P + ((cc) & 1) * H_PSZ); const float* P1 = P0 + 4096; \
        _Pragma("unroll") for (int tt = 0; tt < 4; ++tt) { const int t = 4 * w + tt; const float a = P0[t * 128 + lane] + P1[t * 128 + lane], b2 = P0[t * 128 + lane + 64] + P1[t * 128 + lane + 64]; \
            const float rstd = rsqrtf(wave_sum(a * a + b2 * b2) * (1.0f / DV) + EPS); const size_t orow = (size_t)(row0 + (cc) * 32 + t) * DM + h * 128; \
            CAT[orow + lane] = f2bf(a * rstd * gn0 * gprev[2 * tt]); CAT[orow + lane + 64] = f2bf(b2 * rstd * gn1 * gprev[2 * tt + 1]); } } while (0)
    HG_LOAD(0);
    for (int c = 0; c < NCH; ++c) {
        unsigned char* buf = lds + (c & 1) * HB_SZ;
        {
            float bl[8]; float run = 0.f;
#pragma unroll
            for (int i = 0; i < 8; ++i) { run += lf[i]; bl[i] = run; }
            const int kk = lane & 15;
            const float t0 = __shfl(run, kk), t1 = __shfl(run, kk + 16), t2 = __shfl(run, kk + 32), t3 = __shfl(run, kk + 48);
            const float off = (tg > 0 ? t0 : 0.f) + (tg > 1 ? t1 : 0.f) + (tg > 2 ? t2 : 0.f);
            const float blast = (t0 + t1) + (t2 + t3), dd = __builtin_amdgcn_exp2f(blast);
            bseg += blast;
            float kd[8];
#pragma unroll
            for (int i = 0; i < 8; ++i) { const float eb = __builtin_amdgcn_exp2f(bl[i] + off), einv = frcp(eb), kf = __uint_as_float(kq[i] << 16);
                kd[i] = kf * (dd * einv);
                if (FULL) { *(bf16_t*)(buf + HB_QD + ((8 * tg + i) * QP + pk) * 2) = (bf16_t)(pk2(__uint_as_float(qq[i] << 16) * eb, 0.f) & 0xffffu); *(bf16_t*)(buf + HB_KI + ((8 * tg + i) * QP + pk) * 2) = (bf16_t)(pk2(kf * einv, 0.f) & 0xffffu); } }
            u32x4 kw; kw.x = pk2(kd[0], kd[1]); kw.y = pk2(kd[2], kd[3]); kw.z = pk2(kd[4], kd[5]); kw.w = pk2(kd[6], kd[7]);
            *(u32x4*)(buf + HB_KD + (pk * TP + 8 * tg) * 2) = kw;
            u32x4 vw; vw.x = vv[0] | (vv[1] << 16); vw.y = vv[2] | (vv[3] << 16); vw.z = vv[4] | (vv[5] << 16); vw.w = vv[6] | (vv[7] << 16);
            *(u32x4*)(buf + HB_VT + (pk * TP + 8 * tg) * 2) = vw;
            if (tg == 0) *(float*)(buf + HB_DV + pk * 4) = dd;
        }
        float gnew[8];
        if (FULL) {
#pragma unroll
            for (int i = 0; i < 8; ++i) gnew[i] = __uint_as_float(gq[i] << 16); }
        { const int cn = c + 1 < NCH ? c + 1 : c; HG_LOAD(cn); }
        LDS_BARRIER();
        if (FULL && c > 0) HG_FINALIZE(c - 1);
        const unsigned char* qd = buf + HB_QD; const unsigned char* ki = buf + HB_KI; const unsigned char* kdt = buf + HB_KD; const unsigned char* vt = buf + HB_VT; const unsigned char* dv = buf + HB_DV;
        if (FULL) {
            f32x16 sc;
#pragma unroll
            for (int i = 0; i < 16; ++i) sc[i] = 0.f;
            bf16x8 ka[4], qa[4];
#pragma unroll
            for (int st = 0; st < 4; ++st) { const int kc = 64 * kh + 16 * st + 8 * hh; ka[st] = *(const bf16x8*)(ki + (r * QP + kc) * 2); qa[st] = *(const bf16x8*)(qd + (r * QP + kc) * 2); }
            bf16x8 vi[2], qb[2][2];
#pragma unroll
            for (int s = 0; s < 2; ++s) { const s16x4 lo = *(const s16x4*)(vt + ((32 * vb + r) * TP + 16 * s + 4 * hh) * 2), hi = *(const s16x4*)(vt + ((32 * vb + r) * TP + 16 * s + 8 + 4 * hh) * 2);
                vi[s] = (bf16x8){lo[0], lo[1], lo[2], lo[3], hi[0], hi[1], hi[2], hi[3]}; }
#pragma unroll
            for (int a2 = 0; a2 < 2; ++a2)
#pragma unroll
                for (int s = 0; s < 2; ++s) { const int kc = 32 * (2 * kh + a2) + 16 * s + 4 * hh;
                    const s16x4 lo = *(const s16x4*)(qd + (r * QP + kc) * 2), hi = *(const s16x4*)(qd + (r * QP + kc + 8) * 2); qb[a2][s] = (bf16x8){lo[0], lo[1], lo[2], lo[3], hi[0], hi[1], hi[2], hi[3]}; }
#pragma unroll
            for (int st = 0; st < 4; ++st) sc = HG_MFMA(ka[st], qa[st], sc);
#pragma unroll
            for (int g = 0; g < 4; ++g)
#pragma unroll
                for (int i = 0; i < 4; ++i) if (8 * g + 4 * hh + i > r) sc[4 * g + i] = 0.f;
            f32x16 oacc;
#pragma unroll
            for (int i = 0; i < 16; ++i) oacc[i] = 0.f;
#pragma unroll
            for (int s = 0; s < 2; ++s) { const bf16x8 a = pack8(sc, s); oacc = HG_MFMA(a, vi[s], oacc); }
#pragma unroll
            for (int a2 = 0; a2 < 2; ++a2)
#pragma unroll
                for (int s = 0; s < 2; ++s) { const bf16x8 bS = pack8(S[a2], s); oacc = HG_MFMA(qb[a2][s], bS, oacc); }
            float* P = (float*)(lds + H_P + (c & 1) * H_PSZ) + kh * 4096;
#pragma unroll
            for (int g = 0; g < 4; ++g)
#pragma unroll
                for (int i = 0; i < 4; ++i) P[(8 * g + 4 * hh + i) * 128 + 32 * vb + r] = oacc[4 * g + i];
        }
        { bf16x8 da[2][2], db[2]; f32x4 dd4[2][4];
#pragma unroll
          for (int s = 0; s < 2; ++s) db[s] = *(const bf16x8*)(vt + ((32 * vb + r) * TP + 16 * s + 8 * hh) * 2);
#pragma unroll
          for (int a2 = 0; a2 < 2; ++a2) { const int kt = 2 * kh + a2;
#pragma unroll
              for (int s = 0; s < 2; ++s) da[a2][s] = *(const bf16x8*)(kdt + ((32 * kt + r) * TP + 16 * s + 8 * hh) * 2);
#pragma unroll
              for (int g = 0; g < 4; ++g) dd4[a2][g] = *(const f32x4*)(dv + (32 * kt + 8 * g + 4 * hh) * 4); }
#pragma unroll
          for (int a2 = 0; a2 < 2; ++a2) {
#pragma unroll
              for (int g = 0; g < 4; ++g)
#pragma unroll
                  for (int i = 0; i < 4; ++i) S[a2][4 * g + i] *= dd4[a2][g][i];
#pragma unroll
              for (int s = 0; s < 2; ++s) S[a2] = HG_MFMA(da[a2][s], db[s], S[a2]); } }
        if (FULL) {
#pragma unroll
            for (int i = 0; i < 8; ++i) gprev[i] = gnew[i]; }
    }
    if (FULL) { LDS_BARRIER(); HG_FINALIZE(NCH - 1); }
#undef HG_FINALIZE
#undef HG_LOAD
    if (FULL) { if (seg == NSEG - 1) { float* so = p.out + O_SHP + (size_t)bh * DK * DV;
#pragma unroll
        for (int a = 0; a < 2; ++a)
#pragma unroll
            for (int g = 0; g < 4; ++g)
#pragma unroll
                for (int i = 0; i < 4; ++i) so[(size_t)(32 * (2 * kh + a) + 8 * g + 4 * hh + i) * DV + 32 * vb + r] = S[a][4 * g + i]; }
    } else { float* so = SLOC + (size_t)(bh * NSEG + seg) * DK * DV + (size_t)(w * 8 * 64 + lane) * 4;
#pragma unroll
        for (int a = 0; a < 2; ++a)
#pragma unroll
            for (int g = 0; g < 4; ++g) *(f32x4*)(so + (a * 4 + g) * 256) = (f32x4){S[a][4 * g], S[a][4 * g + 1], S[a][4 * g + 2], S[a][4 * g + 3]}; }
    if (!FULL && tg == 0) SDEC[(size_t)(bh * NSEG + seg) * DK + pk] = __builtin_amdgcn_exp2f(bseg);
    LDS_BARRIER();
}

template <int TT>
__device__ __forceinline__ void conv_pair(const Params& p, unsigned char* lds, bool sample, int tile) {
    int tid = threadIdx.x; asm volatile("" : "+v"(tid));
    const int half = tid >> 8, cp = tid & 255, lane = tid & 63, wq = (tid >> 6) & 3;
    unsigned char* ws = p.ws; const bf16_t* U = (const bf16_t*)(ws + WS_U); bf16_t* CAT = (bf16_t*)(ws + WS_CAT);
    const int sq = sample ? tile : tile >> 7, t0 = sample ? 0 : (tile & 127) * 16;
    const int row0 = sample ? MP + sq * DS : sq * SEQ + t0;
    float* zb = (float*)lds + (size_t)half * (TT * MIXB);
    const f32x4 g0 = *(const f32x4*)(p.in[I_CLG] + 8 * lane), g1 = *(const f32x4*)(p.in[I_CLG] + 8 * lane + 4), b0 = *(const f32x4*)(p.in[I_CLB] + 8 * lane), b1 = *(const f32x4*)(p.in[I_CLB] + 8 * lane + 4);
    if (tile >= 0) {
        f32x2v w[CW];
#pragma unroll
        for (int j = 0; j < CW; ++j) w[j] = *(const f32x2v*)(p.in[I_CDW] + j * MIXB + 2 * cp);
        const f32x2v bias = *(const f32x2v*)(p.in[I_CDB] + 2 * cp);
        f32x2v acc[TT];
#pragma unroll
        for (int t = 0; t < TT; ++t) acc[t] = bias;
#pragma unroll
        for (int r = 0; r < TT + CW - 1; ++r) {
            f32x2v val;
            if (sample && r < CW - 1) val = __builtin_nontemporal_load((const f32x2v*)(p.in[I_SC] + ((size_t)sq * (CW - 1) + r) * MIXB + 2 * cp));
            else { const int i = t0 + r - (CW - 1); unsigned raw = 0u; if (sample || i >= 0) raw = *(const unsigned*)(U + (size_t)(sample ? row0 + r - (CW - 1) : sq * SEQ + i) * MIXB + 2 * cp);
                val[0] = __uint_as_float(raw << 16); val[1] = __uint_as_float(raw & 0xffff0000u); }
#pragma unroll
            for (int t = 0; t < TT; ++t) { const int j = r - t; if (j >= 0 && j < CW) acc[t] += w[j] * val; }
        }
#pragma unroll
        for (int t = 0; t < TT; ++t) *(f32x2v*)(zb + t * MIXB + 2 * cp) = acc[t];
    }
    LDS_BARRIER();
    if (tile >= 0) {
#pragma unroll
        for (int tt = 0; tt < TT / 4; ++tt) { const int t = wq * (TT / 4) + tt;
            const f32x4 z0 = *(const f32x4*)(zb + t * MIXB + 8 * lane), z1 = *(const f32x4*)(zb + t * MIXB + 8 * lane + 4);
            const float s1 = wave_sum((z0[0] + z0[1]) + (z0[2] + z0[3]) + (z1[0] + z1[1]) + (z1[2] + z1[3]));
            const float mu = s1 * (1.0f / MIXB); const f32x4 d0 = z0 - mu, d1 = z1 - mu;
            const float s2 = wave_sum((d0[0] * d0[0] + d0[1] * d0[1]) + (d0[2] * d0[2] + d0[3] * d0[3]) + (d1[0] * d1[0] + d1[1] * d1[1]) + (d1[2] * d1[2] + d1[3] * d1[3]));
            const float rstd = rsqrtf(s2 * (1.0f / MIXB) + EPS);
            f32x4 y0 = d0 * rstd * g0 + b0, y1 = d1 * rstd * g1 + b1;
#pragma unroll
            for (int j = 0; j < 4; ++j) { y0[j] = siluf_(y0[j]); y1[j] = siluf_(y1[j]); }
            u32x4 o; o.x = cvt_pk_bf16(y0[0], y0[1]); o.y = cvt_pk_bf16(y0[2], y0[3]); o.z = cvt_pk_bf16(y1[0], y1[1]); o.w = cvt_pk_bf16(y1[2], y1[3]);
            *(u32x4*)(CAT + (size_t)(row0 + t) * DM + MIXA + 8 * lane) = o; }
    }
    LDS_BARRIER();
}

constexpr int CONV_MOVED = NB * HEADS * 8;
static_assert(CONV_MOVED <= NB * (SEQ / 16) / 2, "conv split");
constexpr int LDS_BYTES = LDS_MAIN + 256;
__global__ void __launch_bounds__(512, 2) hymba_fwd(Params p) {
    extern __shared__ __attribute__((aligned(16))) unsigned char lds[];
    cg::grid_group grid = cg::this_grid();
    unsigned char* ws = p.ws;
    PG8_LAS unsigned char* glds = (PG8_LAS unsigned char*)lds;
    const int G = gridDim.x, bx = blockIdx.x;
    if (p.ws == nullptr) grid.sync();
    volatile XLAS unsigned* xst = (volatile XLAS unsigned*)(glds + LDS_MAIN);
    if (threadIdx.x < 4) xst[threadIdx.x] = 0u;
    __syncthreads();
    const XcdBarrier gbar = xcd_barrier_post((unsigned*)(ws + WS_BAR), xst);

    p0_prologue(p, lds);
    xcd_barrier(gbar);
    {
        pg8::Gemm g{(const bf16_t*)(ws + WS_XN), (const bf16_t*)(ws + WS_W1), MT, DIN, DM}; pg8::StaticOrder S; S.init(MP, DIN, G, bx);
        Epi1 E{(bf16_t*)(ws + WS_Q), (bf16_t*)(ws + WS_K), (bf16_t*)(ws + WS_V), (bf16_t*)(ws + WS_G), (bf16_t*)(ws + WS_U), (float*)(ws + WS_LOGF), (const float*)(ws + WS_LB), p.out + O_SCP, p.out + O_SCS};
        pg8::gemm_phase(glds, g, S, E);
        for (int u = bx; u < 16 * 48; u += G) { const int rb = u / 48, ct = u % 48; int br0, br1;
            if (ct < 32) { br0 = ct * 64; br1 = br0 + 32; } else { br0 = 2048 + ((ct - 32) >> 2) * 256 + ((ct - 32) & 3) * 32; br1 = br0 + 128; }
            small_gemm<DM>(lds, g.A, g.Bt, MP + 32 * rb, permcol(br0), permcol(br1), E); }
    }
    xcd_barrier(gbar);
    {
        for (int u = bx; u < NB * HEADS * (NSEG - 1); u += G) hgrn_seg<false>(p, lds, u / (HEADS * (NSEG - 1)), (u / (NSEG - 1)) % HEADS, u % (NSEG - 1));
        for (int u = G - 1 - bx; u < DB * HEADS / 2; u += G) hgrn_sample_pair(p, (float*)lds, 2 * u + (threadIdx.x >> 8));
        for (int u = CONV_MOVED + bx; u < NB * (SEQ / 16) / 2; u += G) conv_pair<16>(p, lds, false, 2 * u + (threadIdx.x >> 8));
        { const int ib = G - 1 - bx, nb2 = G < 32 ? G : 32;
          if (ib < nb2) for (int u = ib; u < DB / 2; u += nb2) conv_pair<DS>(p, lds, true, 2 * u + (threadIdx.x >> 8)); }
    }
    xcd_barrier(gbar);
    {
        for (int u = bx; u < NB * HEADS * NSEG; u += G) { hgrn_seg<true>(p, lds, u >> 5, (u >> 3) & 3, u & 7);
            const int seg = u & 7, ne = seg < 2 ? 2 : (seg < 6 ? 1 : 0), o0 = (int)((0x88765420u >> (4 * seg)) & 15u);
            for (int k = 0; k < ne; ++k) conv_pair<16>(p, lds, false, 2 * ((u >> 3) * 8 + o0 + k) + (threadIdx.x >> 8)); }
    }
    xcd_barrier(gbar);
    {
        pg8::Gemm g{(const bf16_t*)(ws + WS_CAT), (const bf16_t*)(ws + WS_W2), MT, DM, DM}; pg8::StaticOrder S; S.init(MP, DM, G, bx);
        EpiRes<false> E{p.in[I_XP], p.in[I_XS], (bf16_t*)(ws + WS_HB), (float*)(ws + WS_SS1), (bf16_t*)(ws + WS_HB)};
        pg8::gemm_phase(glds, g, S, E);
        for (int u = bx; u < 256; u += G) small_gemm<DM>(lds, g.A, g.Bt, MP + 32 * (u >> 4), (u & 15) * 64, (u & 15) * 64 + 32, E);
    }
    xcd_barrier(gbar);
    {
        pg8::Gemm g{(const bf16_t*)(ws + WS_HB), (const bf16_t*)(ws + WS_W3), MT, 2 * DFF, DM}; OrderFfn S; S.init(G, bx);
        EpiSwi E{(const float*)(ws + WS_SS1), (bf16_t*)(ws + WS_ACT)};
        pg8::gemm_phase(glds, g, S, E);
    }
    xcd_barrier(gbar);
    {
        pg8::Gemm g{(const bf16_t*)(ws + WS_ACT), (const bf16_t*)(ws + WS_W4), MT, DM, DFF}; pg8::StaticOrder S; S.init(MP, DM, G, bx);
        EpiRes<true> E{nullptr, nullptr, (bf16_t*)(ws + WS_HB), (float*)(ws + WS_SS2), (bf16_t*)(ws + WS_HB)};
        pg8::gemm_phase(glds, g, S, E);
        for (int u = bx; u < 256; u += G) small_gemm<DFF>(lds, g.A, g.Bt, MP + 32 * (u >> 4), (u & 15) * 64, (u & 15) * 64 + 32, E);
    }
    xcd_barrier(gbar);
    {
        pg8::StaticOrder S; S.init(MP, DM, G, bx);
        { pg8::Gemm g{(const bf16_t*)(ws + WS_PB), (const bf16_t*)(ws + WS_W6), MT, DM, DPLE}; EpiBf E{(bf16_t*)(ws + WS_PP)}; pg8::gemm_phase(glds, g, S, E);
          for (int u = bx; u < 256; u += G) small_gemm<DPLE>(lds, g.A, g.Bt, MP + 32 * (u >> 4), (u & 15) * 64, (u & 15) * 64 + 32, E);
          asm volatile("s_waitcnt vmcnt(0)" ::: "memory"); }
        { pg8::Gemm g{(const bf16_t*)(ws + WS_HB), (const bf16_t*)(ws + WS_W5), MT, DM, DM}; EpiPle E{(const float*)(ws + WS_SS2), (const bf16_t*)(ws + WS_PP), (const bf16_t*)(ws + WS_HB), (bf16_t*)(ws + WS_H3), (float*)(ws + WS_SS3)}; pg8::gemm_phase(glds, g, S, E);
          for (int u = bx; u < 256; u += G) small_gemm<DM>(lds, g.A, g.Bt, MP + 32 * (u >> 4), (u & 15) * 64, (u & 15) * 64 + 32, E); }
    }
    xcd_barrier(gbar);
    {
        const int lane = threadIdx.x & 63, gw = bx * 8 + (threadIdx.x >> 6), NGW = G * 8;
        const f32x4* gp = (const f32x4*)p.in[I_NFIN] + lane; f32x4 gv[4];
#pragma unroll
        for (int j = 0; j < 4; ++j) gv[j] = gp[64 * j];
        const bf16_t* H3 = (const bf16_t*)(ws + WS_H3); const float* ss3 = (const float*)(ws + WS_SS3);
        for (int m0 = 2 * gw; m0 < MT; m0 += 2 * NGW) { const int m1 = m0 + 1;
            const float r0 = rsqrtf(ss3[m0] * (1.0f / DM) + EPS), r1 = rsqrtf(ss3[m1] * (1.0f / DM) + EPS);
            u32x2 h0[4], h1[4];
#pragma unroll
            for (int j = 0; j < 4; ++j) { h0[j] = __builtin_nontemporal_load((const u32x2*)(H3 + (size_t)m0 * DM) + lane + 64 * j); h1[j] = __builtin_nontemporal_load((const u32x2*)(H3 + (size_t)m1 * DM) + lane + 64 * j); }
#pragma unroll
            for (int j = 0; j < 4; ++j) { __builtin_nontemporal_store(unpack4(h0[j]) * r0 * gv[j], (f32x4*)(p.out + (size_t)m0 * DM) + lane + 64 * j); __builtin_nontemporal_store(unpack4(h1[j]) * r1 * gv[j], (f32x4*)(p.out + (size_t)m1 * DM) + lane + 64 * j); } }
    }
}

extern "C" void kernel_launch(void* const* d_in, const int* in_sizes, int n_in, void* d_out, int out_size, void* d_ws, size_t ws_size, hipStream_t stream) {
    static int grid_blocks = 0;
    if (!grid_blocks) {
        if (n_in != 23 || (size_t)out_size != O_END || ws_size < WS_END) { fprintf(stderr, "kernel_launch: unexpected shapes: n_in %d out %d (want %zu) ws %zu (need %zu)\n", n_in, out_size, (size_t)O_END, ws_size, (size_t)WS_END); }
        int dev = 0, cus = 0, per_cu = 0;
        hipGetDevice(&dev); hipDeviceGetAttribute(&cus, hipDeviceAttributeMultiprocessorCount, dev);
        hipFuncSetAttribute((const void*)hymba_fwd, hipFuncAttributeMaxDynamicSharedMemorySize, LDS_BYTES);
        hipOccupancyMaxActiveBlocksPerMultiprocessor(&per_cu, (const void*)hymba_fwd, 512, LDS_BYTES);
        if (per_cu < 1) { fprintf(stderr, "kernel_launch: occupancy query says %d blocks per CU\n", per_cu); per_cu = 1; }
        grid_blocks = cus;
    }
    Params p{};
    for (int i = 0; i < 23; ++i) p.in[i] = (const float*)d_in[i];
    p.out = (float*)d_out; p.ws = (unsigned char*)d_ws;
    if (hipMemsetAsync((char*)d_ws + WS_BAR, 0, WS_BAR_BYTES, stream) != hipSuccess) fprintf(stderr, "kernel_launch: memset of the barrier words failed\n");
    void* args[] = {&p};
    hipError_t e = hipLaunchCooperativeKernel((const void*)hymba_fwd, dim3(grid_blocks), dim3(512), args, LDS_BYTES, stream);
    if (e != hipSuccess) fprintf(stderr, "cooperative launch failed: %s (grid %d)\n", hipGetErrorString(e), grid_blocks);
}
```

```cpp
#include <hip/hip_runtime.h>
#include <hip/hip_cooperative_groups.h>
#include <cstdio>
#include <cstdint>
namespace cg = cooperative_groups;

namespace pg8 {
#define PG8_LAS __attribute__((address_space(3)))
typedef unsigned short bf16_t;
typedef short bf16x8 __attribute__((ext_vector_type(8)));
typedef float f32x4 __attribute__((ext_vector_type(4)));
typedef unsigned u32x4 __attribute__((ext_vector_type(4)));
typedef unsigned u32x2 __attribute__((ext_vector_type(2)));
constexpr int BM = 256, BK = 64, HALF = 128, HTB = HALF * BK * 2, STAGE_BYTES = 8 * HTB, NXCD = 8, WGM = 8;

__host__ __device__ __forceinline__ int lds_byte(int r, int c) { const int st = (r >> 4) * 2 + (c >> 5), rr = r & 15, cc = c & 31, ob = rr * 64 + cc * 2; return st * 1024 + (ob ^ (((ob >> 9) & 1) << 5)); }
__host__ __device__ __forceinline__ void stage_rc(int b, int& R, int& C) { const int st = b / 1024, sb = b % 1024, swz = sb ^ (((sb >> 9) & 1) << 5); R = (st >> 1) * 16 + swz / 64; C = (st & 1) * 32 + (swz % 64) / 2; }
__host__ __device__ __forceinline__ int perm32(int rho) { const int n = rho >> 4, i = rho & 15; return 8 * (i >> 2) + 4 * n + (i & 3); }

struct Unit { int pm, pn; };
struct Gemm { const bf16_t* A; const bf16_t* Bt; int M, N, K; };

struct StaticOrder {
    int nM, nN, nwg, G, c;
    __host__ __device__ void init(int M, int N, int G_, int c_) { nM = M / BM; nN = N / BM; nwg = nM * nN; G = G_; c = c_; }
    __host__ __device__ bool next(int i, Unit& u) const {
        const long L = (long)i * G + c; if (L >= nwg) return false;
        int wgid = (int)L; { const int q = nwg / NXCD, r = nwg % NXCD, xcd = wgid % NXCD, off = wgid / NXCD; wgid = (xcd < r ? xcd * (q + 1) : r * (q + 1) + (xcd - r) * q) + off; }
        const int nig = WGM * nN, gid = wgid / nig, fm = gid * WGM, gsz = (nM - fm) < WGM ? (nM - fm) : WGM;
        u.pm = fm + ((wgid % nig) % gsz); u.pn = (wgid % nig) / gsz; return true;
    }
    __device__ __forceinline__ void a_ready(const Unit&) const {}
    __device__ __forceinline__ void done(const Unit&) const {}
};

__device__ __forceinline__ unsigned cvt_pk_bf16(float lo, float hi) { unsigned r; asm volatile("v_cvt_pk_bf16_f32 %0, %1, %2" : "=v"(r) : "v"(lo), "v"(hi)); return r; }

template <class Epi, class Sched>
__device__ __forceinline__ void gemm_phase(PG8_LAS unsigned char* lds, const Gemm g, const Sched& S, const Epi& E) {
    int tid = threadIdx.x; asm volatile("" : "+v"(tid));
    const int wid = __builtin_amdgcn_readfirstlane(tid >> 6), lane = tid & 63, wr = wid >> 2, wc = wid & 3, fr = lane & 15, fq = lane >> 4;
    const int K = g.K, nt = K / BK;
    unsigned voffA[2], voffB[2];
#pragma unroll
    for (int i = 0; i < 2; ++i) { int R, C; stage_rc(tid * 16 + i * 8192, R, C); const int Rb = Epi::PERM ? ((R & ~31) + perm32(R & 31)) : R;
        voffA[i] = (unsigned)(R * K + C) * 2u; voffB[i] = (unsigned)(Rb * K + C) * 2u; }
    const size_t kstep = (size_t)(BK * 2);
    const size_t hstep = (size_t)HALF * K * 2;
    const size_t tstep = 2 * hstep;
    const unsigned ldsw = (unsigned)wid * 1024u;
    const int aoff = lds_byte(wr * 64 + fr, fq * 8), boff = lds_byte(wc * 32 + fr, fq * 8);
#define PG8_SA(b, h) (((b) * 2 + (h)) * HTB)
#define PG8_SB(b, h) ((4 + (b) * 2 + (h)) * HTB)
#define PG8_STAGE(bufoff, gbase, voff) do { _Pragma("unroll") for (int _i = 0; _i < 2; ++_i) \
        __builtin_amdgcn_global_load_lds((const unsigned*)((const char*)(gbase) + (voff)[_i]), (PG8_LAS unsigned*)(lds + (bufoff) + ldsw + _i * 8192), 16, 0, 0); } while (0)
#define PG8_LDA(dst, b, h) do { _Pragma("unroll") for (int m = 0; m < 4; ++m) _Pragma("unroll") for (int k = 0; k < 2; ++k) dst[m][k] = *(const PG8_LAS bf16x8*)(lds + PG8_SA(b, h) + aoff + m * 2048 + k * 1024); } while (0)
#define PG8_LDB(dst, b, h) do { _Pragma("unroll") for (int n = 0; n < 2; ++n) _Pragma("unroll") for (int k = 0; k < 2; ++k) dst[n][k] = *(const PG8_LAS bf16x8*)(lds + PG8_SB(b, h) + boff + n * 2048 + k * 1024); } while (0)
#define PG8_MMA(ai, bj, At, Bt) do { __builtin_amdgcn_s_setprio(1); _Pragma("unroll") for (int m = 0; m < 4; ++m) _Pragma("unroll") for (int n = 0; n < 2; ++n) _Pragma("unroll") for (int k = 0; k < 2; ++k) \
        acc[ai][bj][m][n] = __builtin_amdgcn_mfma_f32_16x16x32_bf16(Bt[n][k], At[m][k], acc[ai][bj][m][n], 0, 0, 0); __builtin_amdgcn_s_setprio(0); } while (0)
#define PG8_WAIT_V(n) asm volatile("s_waitcnt vmcnt(" #n ")" ::: "memory")
#define PG8_WAIT_L(n) asm volatile("s_waitcnt lgkmcnt(" #n ")" ::: "memory")
#define PG8_BAR __builtin_amdgcn_s_barrier()
#define PG8_SCHED __builtin_amdgcn_sched_barrier(0)
    Unit cur, nxt; int ui = 0;
    if (!S.next(0, cur)) return;
    f32x4 acc[2][2][4][2];
#pragma unroll
    for (int a = 0; a < 2; ++a)
#pragma unroll
        for (int b = 0; b < 2; ++b)
#pragma unroll
            for (int m = 0; m < 4; ++m)
#pragma unroll
                for (int n = 0; n < 2; ++n) acc[a][b][m][n] = (f32x4){0.f, 0.f, 0.f, 0.f};
    bf16x8 At[4][2], B0[2][2], B1[2][2];
    const char* cA = (const char*)g.A + (size_t)cur.pm * tstep; const char* cB = (const char*)g.Bt + (size_t)cur.pn * tstep;
    float epre[Epi::NPRE]; E.preload(cur, wr, fr, epre);
    S.a_ready(cur);
    PG8_STAGE(PG8_SB(0, 0), cB, voffB); PG8_STAGE(PG8_SA(0, 0), cA, voffA); PG8_STAGE(PG8_SB(0, 1), cB + hstep, voffB); PG8_STAGE(PG8_SA(0, 1), cA + hstep, voffA);
    if (wr == 1) PG8_BAR;
    PG8_WAIT_V(4); PG8_BAR;
    PG8_STAGE(PG8_SB(1, 0), cB + kstep, voffB); PG8_STAGE(PG8_SA(1, 0), cA + kstep, voffA); PG8_STAGE(PG8_SB(1, 1), cB + hstep + kstep, voffB);
    PG8_WAIT_V(6); PG8_BAR;
    for (;;) {
        const bool has_next = S.next(ui + 1, nxt);
        const char* nA = has_next ? (const char*)g.A + (size_t)nxt.pm * tstep : cA; const char* nB = has_next ? (const char*)g.Bt + (size_t)nxt.pn * tstep : cB;
        for (int t = 0; t < nt; t += 2) {
            const bool last = (t == nt - 2);
            const char* a1 = cA + (size_t)(t + 1) * kstep;
            const char* a2 = last ? nA : cA + (size_t)(t + 2) * kstep; const char* b2 = last ? nB : cB + (size_t)(t + 2) * kstep;
            const char* a3 = a2 + kstep; const char* b3 = b2 + kstep;
            if (last && has_next) S.a_ready(nxt);
            PG8_LDB(B0, 0, 0); PG8_SCHED; PG8_LDA(At, 0, 0); PG8_STAGE(PG8_SA(1, 1), a1 + hstep, voffA);
            PG8_WAIT_L(8); PG8_BAR; PG8_WAIT_L(0); PG8_MMA(0, 0, At, B0); PG8_BAR; PG8_SCHED;
            PG8_LDB(B1, 0, 1); PG8_STAGE(PG8_SB(0, 0), b2, voffB);
            PG8_BAR; PG8_WAIT_L(0); PG8_MMA(0, 1, At, B1); PG8_BAR;
            PG8_LDA(At, 0, 1); PG8_STAGE(PG8_SA(0, 0), a2, voffA);
            PG8_BAR; PG8_WAIT_L(0); PG8_MMA(1, 0, At, B0); PG8_BAR; PG8_SCHED;
            PG8_STAGE(PG8_SB(0, 1), b2 + hstep, voffB);
            PG8_WAIT_V(6); PG8_BAR; PG8_MMA(1, 1, At, B1); PG8_BAR;
            PG8_LDB(B0, 1, 0); PG8_SCHED; PG8_LDA(At, 1, 0); PG8_STAGE(PG8_SA(0, 1), a2 + hstep, voffA);
            PG8_WAIT_L(8); PG8_BAR; PG8_WAIT_L(0); PG8_MMA(0, 0, At, B0); PG8_BAR; PG8_SCHED;
            PG8_LDB(B1, 1, 1); PG8_STAGE(PG8_SB(1, 0), b3, voffB);
            PG8_BAR; PG8_WAIT_L(0); PG8_MMA(0, 1, At, B1); PG8_BAR;
            PG8_LDA(At, 1, 1); PG8_STAGE(PG8_SA(1, 0), a3, voffA);
            PG8_BAR; PG8_WAIT_L(0); PG8_MMA(1, 0, At, B0); PG8_BAR; PG8_SCHED;
            PG8_STAGE(PG8_SB(1, 1), b3 + hstep, voffB);
            PG8_WAIT_V(6); PG8_BAR; PG8_MMA(1, 1, At, B1); PG8_BAR;
        }
        E(acc, cur, wr, wc, fr, fq, epre); S.done(cur);
        if (!has_next) break;
        E.preload(nxt, wr, fr, epre);
#pragma unroll
        for (int a = 0; a < 2; ++a)
#pragma unroll
            for (int b = 0; b < 2; ++b)
#pragma unroll
                for (int m = 0; m < 4; ++m)
#pragma unroll
                    for (int n = 0; n < 2; ++n) acc[a][b][m][n] = (f32x4){0.f, 0.f, 0.f, 0.f};
        cur = nxt; cA = nA; cB = nB; ++ui;
    }
    PG8_WAIT_V(0);
    if (wr == 0) PG8_BAR;
    PG8_BAR;
#undef PG8_SA
#undef PG8_SB
#undef PG8_STAGE
#undef PG8_LDA
#undef PG8_LDB
#undef PG8_MMA
#undef PG8_WAIT_V
#undef PG8_WAIT_L
#undef PG8_BAR
#undef PG8_SCHED
}
}

using pg8::bf16_t; using pg8::f32x4; using pg8::u32x4; using pg8::u32x2; using pg8::Unit; using pg8::cvt_pk_bf16;

constexpr int DM = 1024, NB = 8, SEQ = 2048, MP = NB * SEQ, DB = 128, DS = 4, MS = DB * DS, MT = MP + MS;
constexpr int MIXA = 512, HEADS = 4, DK = 128, DV = 128, MIXB = 512, CW = 31, DIN = 3072, DFF = 2816, DPLE = 256;
constexpr float EPS = 1e-6f;
static_assert(MT % 256 == 0, "rows");

constexpr size_t O_YP = 0, O_YS = O_YP + (size_t)MP * DM, O_SHP = O_YS + (size_t)MS * DM, O_SCP = O_SHP + (size_t)NB * HEADS * DK * DV,
                 O_SHS = O_SCP + (size_t)NB * (CW - 1) * MIXB, O_SCS = O_SHS + (size_t)DB * HEADS * DK * DV, O_END = O_SCS + (size_t)DB * (CW - 1) * MIXB;

constexpr size_t al256(size_t x) { return (x + 255) & ~(size_t)255; }
constexpr size_t WS_W1 = 0, WS_W2 = WS_W1 + (size_t)DIN * DM * 2, WS_W3 = WS_W2 + (size_t)DM * DM * 2, WS_W4 = WS_W3 + (size_t)2 * DFF * DM * 2,
                 WS_W5 = WS_W4 + (size_t)DM * DFF * 2, WS_W6 = WS_W5 + (size_t)DM * DM * 2, WS_SMALL = WS_W6 + (size_t)DM * DPLE * 2;
constexpr size_t WS_BAR = WS_SMALL, WS_BAR_BYTES = 3456 * 4;
constexpr size_t WS_LB = WS_BAR + WS_BAR_BYTES, WS_SS1 = WS_LB + 4096, WS_SS2 = WS_SS1 + al256((size_t)MT * 4), WS_SS3 = WS_SS2 + al256((size_t)MT * 4), WS_PB = WS_SS3 + al256((size_t)MT * 4);
constexpr size_t WS_C = WS_PB + (size_t)MT * DPLE * 2;
constexpr size_t SZ_H512 = (size_t)MT * 512 * 2;
constexpr size_t WS_Q = WS_C, WS_K = WS_Q + SZ_H512, WS_V = WS_K + SZ_H512, WS_G = WS_V + SZ_H512, WS_U = WS_G + SZ_H512, WS_LOGF = WS_U + SZ_H512, WS_C_END = WS_LOGF + (size_t)MT * 512 * 4;
constexpr size_t WS_HB = WS_C, WS_H3 = WS_HB + (size_t)MT * DM * 2;
static_assert(WS_H3 + (size_t)MT * DM * 2 <= WS_C_END, "overlay");
constexpr size_t WS_D = WS_C_END;
constexpr size_t WS_XN = WS_D, WS_CAT = WS_D, WS_ACT = WS_D, WS_PP = WS_D, WS_END = WS_D + (size_t)MT * DFF * 2;
constexpr int NSEG = 8, SEGL = SEQ / NSEG, NCH = SEGL / 32;
constexpr size_t WS_SLOC = WS_D + (size_t)MT * DM * 2, WS_SDEC = WS_SLOC + (size_t)NB * HEADS * NSEG * DK * DV * 4;
static_assert(WS_SDEC + (size_t)NB * HEADS * NSEG * DK * 4 <= WS_END, "overlay");

struct Params { const float* in[23]; float* out; unsigned char* ws; };
enum { I_XP = 0, I_XS, I_PP, I_PS, I_SH, I_SC, I_NMIX, I_WIN, I_LBL, I_HON, I_CDW, I_CDB, I_CLG, I_CLB, I_WOUT, I_NFFN, I_WG, I_WU, I_WD, I_NPLE, I_WPG, I_WPP, I_NFIN };

__device__ __forceinline__ float bf2f(bf16_t b) { return __uint_as_float(((unsigned)b) << 16); }
__device__ __forceinline__ bf16_t f2bf(float f) { return (bf16_t)(cvt_pk_bf16(f, 0.f) & 0xffffu); }
template <int CTRL> __device__ __forceinline__ float dpp_step(float t) { return t + __builtin_bit_cast(float, __builtin_amdgcn_update_dpp(0, __builtin_bit_cast(int, t), CTRL, 0xF, 0xF, true)); }
__device__ __forceinline__ float wave_sum(float v) {
    float t = dpp_step<0xB1>(v);
    t = dpp_step<0x4E>(t);
    t = dpp_step<0x141>(t);
    t = dpp_step<0x140>(t);
    const int ti = __builtin_bit_cast(int, t);
    return (__builtin_bit_cast(float, __builtin_amdgcn_readlane(ti, 0)) + __builtin_bit_cast(float, __builtin_amdgcn_readlane(ti, 16)))
         + (__builtin_bit_cast(float, __builtin_amdgcn_readlane(ti, 32)) + __builtin_bit_cast(float, __builtin_amdgcn_readlane(ti, 48)));
}
__device__ __forceinline__ float frcp(float x) { return __builtin_amdgcn_rcpf(x); }
__device__ __forceinline__ float sigmoidf_(float x) { return frcp(1.0f + __expf(-x)); }
__device__ __forceinline__ float siluf_(float x) { return x * frcp(1.0f + __expf(-x)); }

#define XB_TMO      128
#define XB_XCNT(j)  (256  + 64 * (j))
#define XB_XSUB(j)  (1280 + 64 * (j))
#define XB_XGEN(j)  (2304 + 64 * (j))
#define XB_TOP      3328
#define XB_TOPGEN   3392
#define XCD_BAR_WORDS 3456
#define XB_SPIN_CAP (1u << 18)
#define XLAS __attribute__((address_space(3)))

__device__ __forceinline__ unsigned xb_ld(unsigned* p)              { return __hip_atomic_load(p, __ATOMIC_RELAXED, __HIP_MEMORY_SCOPE_AGENT); }
__device__ __forceinline__ unsigned xb_add(unsigned* p, unsigned v) { return __hip_atomic_fetch_add(p, v, __ATOMIC_RELAXED, __HIP_MEMORY_SCOPE_AGENT); }
__device__ __forceinline__ unsigned xb_xcc_id() { return (unsigned)__builtin_amdgcn_s_getreg((3 << 11) | 20) & 0xFu; }
#define XB_SPIN(cond, bar) do { unsigned _sp = 0; while (cond) { __builtin_amdgcn_s_sleep(1); \
    if ((++_sp & 255u) == 0u) { if (xb_ld(&(bar)[XB_TMO])) break; if (_sp > XB_SPIN_CAP) { atomicAdd(&(bar)[XB_TMO], 1u); break; } } } } while (0)

struct XcdBarrier {
    unsigned* bar; unsigned x;
    volatile XLAS unsigned* st;
};

__device__ __forceinline__ XcdBarrier xcd_barrier_post(unsigned* bar, volatile XLAS unsigned* st) {
    XcdBarrier b; b.bar = bar; b.x = xb_xcc_id(); b.st = st;
    if (threadIdx.x == 0) (void)xb_add(&bar[XB_XCNT(b.x)], 1u);
    return b;
}
__device__ __forceinline__ void xcd_barrier_complete(unsigned* bar, unsigned x, unsigned& nloc, unsigned& nx) {
    const unsigned G = gridDim.x * gridDim.y * gridDim.z;
    unsigned sum, cnt, mine, sp = 0u;
    for (;;) {
        sum = 0u; cnt = 0u; mine = 0u;
#pragma unroll
        for (unsigned j = 0; j < 16; ++j) { const unsigned c = xb_ld(&bar[XB_XCNT(j)]); sum += c; cnt += (c > 0u) ? 1u : 0u; mine = (j == x) ? c : mine; }
        if (sum == G) break;
        __builtin_amdgcn_s_sleep(1);
        if ((++sp & 255u) == 0u) { if (xb_ld(&bar[XB_TMO])) break; if (sp > XB_SPIN_CAP) { atomicAdd(&bar[XB_TMO], 1u); break; } }
    }
    nloc = mine > 0u ? mine : 1u; nx = cnt > 0u ? cnt : 1u;
}

__device__ __forceinline__ void xcd_barrier(const XcdBarrier& b) {
    asm volatile("s_waitcnt vmcnt(0)" ::: "memory");
    __syncthreads();
    if (threadIdx.x == 0) {
        unsigned* bar = b.bar;
        __builtin_amdgcn_s_waitcnt(0);
        unsigned nloc = b.st[0], nx = b.st[1];
        if (nloc == 0u) { xcd_barrier_complete(bar, b.x, nloc, nx); b.st[0] = nloc; b.st[1] = nx; }
        const unsigned old = xb_add(&bar[XB_XSUB(b.x)], 1u);
        const unsigned gen = old / nloc;
        if (old + 1u == (gen + 1u) * nloc) {
            __builtin_amdgcn_fence(__ATOMIC_RELEASE, "agent");
            asm volatile("s_waitcnt vmcnt(0)" ::: "memory");
            const unsigned og = xb_add(&bar[XB_TOP], 1u);
            const unsigned tg = og / nx;
            if (og + 1u == (tg + 1u) * nx) xb_add(&bar[XB_TOPGEN], 1u);
            else XB_SPIN(xb_ld(&bar[XB_TOPGEN]) == tg, bar);
            __builtin_amdgcn_fence(__ATOMIC_ACQUIRE, "agent");
            xb_add(&bar[XB_XGEN(b.x)], 1u);
            asm volatile("s_waitcnt vmcnt(0)" ::: "memory");
        } else {
            XB_SPIN(xb_ld(&bar[XB_XGEN(b.x)]) == gen, bar);
            __builtin_amdgcn_fence(__ATOMIC_ACQUIRE, "agent");
            asm volatile("s_waitcnt vmcnt(0)" ::: "memory");
        }
    }
    __syncthreads();
}


typedef float f32x16 __attribute__((ext_vector_type(16)));
typedef float f32x2v __attribute__((ext_vector_type(2)));
typedef __bf16 b16x2v __attribute__((ext_vector_type(2)));
typedef short s16x4 __attribute__((ext_vector_type(4)));
using pg8::bf16x8;
__device__ __forceinline__ unsigned pk2(float a, float b) { f32x2v v = {a, b}; b16x2v r = __builtin_convertvector(v, b16x2v); return __builtin_bit_cast(unsigned, r); }
#define HG_MFMA(a, b, c) __builtin_amdgcn_mfma_f32_32x32x16_bf16((a), (b), (c), 0, 0, 0)

#define LDS_BARRIER() do { asm volatile("s_waitcnt lgkmcnt(0)" ::: "memory"); __builtin_amdgcn_s_barrier(); asm volatile("" ::: "memory"); } while (0)

constexpr int SG_P = 36;
template <int K, class Epi>
__device__ __forceinline__ void small_gemm(unsigned char* lds, const bf16_t* A, const bf16_t* Bt, int row0, int br0, int br1, const Epi& E) {
    int tid = threadIdx.x; asm volatile("" : "+v"(tid));
    const int w = __builtin_amdgcn_readfirstlane(tid >> 6), lane = tid & 63, r = lane & 31, hh = lane >> 5;
    constexpr int ks = K >> 3, NS = ks >> 4, UNR = NS <= 8 ? NS : 11; const int k0 = w * ks + 8 * hh;
    const bf16_t* ap = A + (size_t)(row0 + r) * K + k0; const bf16_t* b0p = Bt + (size_t)(br0 + r) * K + k0; const bf16_t* b1p = Bt + (size_t)(br1 + r) * K + k0;
    typename Epi::SPre spre; const int srow = row0 + ((tid >> 3) & 31), sc4 = (tid & 7) * 4;
    if (tid < 256) E.small_pre(srow, br0 + sc4, br1 + sc4, spre);
    f32x16 acc0, acc1;
#pragma unroll
    for (int i = 0; i < 16; ++i) { acc0[i] = 0.f; acc1[i] = 0.f; }
#pragma unroll UNR
    for (int s = 0; s < NS; ++s) { const bf16x8 a = *(const bf16x8*)(ap + 16 * s), b0 = *(const bf16x8*)(b0p + 16 * s), b1 = *(const bf16x8*)(b1p + 16 * s);
        acc0 = HG_MFMA(a, b0, acc0); acc1 = HG_MFMA(a, b1, acc1); }
    float* part = (float*)lds + (size_t)w * (2 * 32 * SG_P);
#pragma unroll
    for (int g = 0; g < 4; ++g)
#pragma unroll
        for (int i = 0; i < 4; ++i) { part[(8 * g + 4 * hh + i) * SG_P + r] = acc0[4 * g + i]; part[(32 + 8 * g + 4 * hh + i) * SG_P + r] = acc1[4 * g + i]; }
    LDS_BARRIER();
    if (tid < 256) { const int row = tid >> 3, c4 = (tid & 7) * 4; f32x4 v0 = {0.f, 0.f, 0.f, 0.f}, v1 = {0.f, 0.f, 0.f, 0.f};
#pragma unroll
        for (int ww = 0; ww < 8; ++ww) { const float* pp = (const float*)lds + (size_t)ww * (2 * 32 * SG_P); v0 += *(const f32x4*)(pp + row * SG_P + c4); v1 += *(const f32x4*)(pp + (32 + row) * SG_P + c4); }
        E.small(row0 + row, br0 + c4, br1 + c4, v0, v1, spre); }
    LDS_BARRIER();
}

__host__ __device__ __forceinline__ int perm12(int s) { return (int)((0xBA5476981032ull >> (4 * s)) & 15ull); }
__host__ __device__ __forceinline__ int permcol(int c) { return perm12(c >> 8) * 256 + (c & 255); }
struct Epi1 {
    static constexpr bool PERM = true;
    bf16_t *Q, *Kk, *V, *G, *U; float* LOGF; const float* LB; float* scp; float* scs;
    static constexpr int NPRE = 1;
    __device__ __forceinline__ void preload(const Unit&, int, int, float (&)[1]) const {}
    __device__ __forceinline__ void operator()(const f32x4 (&acc)[2][2][4][2], const Unit& u, int wr, int wc, int fr, int fq, const float (&epre)[1]) const {
        const int row0 = u.pm * 256 + wr * 64 + fr, pn = perm12(u.pn);
        if (pn < 8) {
            const int type = pn >> 1, cb = (pn & 1) * 256 + wc * 32 + 8 * fq;
            if (type == 1) {
                f32x4 lbv[2][2];
#pragma unroll
                for (int bj = 0; bj < 2; ++bj) { lbv[bj][0] = *(const f32x4*)(LB + cb + bj * 128); lbv[bj][1] = *(const f32x4*)(LB + cb + bj * 128 + 4); }
#pragma unroll
                for (int ai = 0; ai < 2; ++ai)
#pragma unroll
                    for (int m = 0; m < 4; ++m) { const size_t rb = (size_t)(row0 + ai * 128 + m * 16) * 512 + cb;
#pragma unroll
                        for (int bj = 0; bj < 2; ++bj) { f32x4 lg[2], kk[2];
#pragma unroll
                            for (int n = 0; n < 2; ++n)
#pragma unroll
                                for (int j = 0; j < 4; ++j) { const float x = acc[ai][bj][m][n][j]; const float k1 = (1.0f - lbv[bj][n][j]) * frcp(1.0f + __expf(x)); kk[n][j] = k1; lg[n][j] = __log2f(1.0f - k1); }
                            *(f32x4*)(LOGF + rb + bj * 128) = lg[0]; *(f32x4*)(LOGF + rb + bj * 128 + 4) = lg[1];
                            u32x4 w; w.x = cvt_pk_bf16(kk[0][0], kk[0][1]); w.y = cvt_pk_bf16(kk[0][2], kk[0][3]); w.z = cvt_pk_bf16(kk[1][0], kk[1][1]); w.w = cvt_pk_bf16(kk[1][2], kk[1][3]);
                            *(u32x4*)(Kk + rb + bj * 128) = w; } }
            } else {
                bf16_t* dst = Q + (size_t)type * ((size_t)MT * 512);
#pragma unroll
                for (int ai = 0; ai < 2; ++ai)
#pragma unroll
                    for (int m = 0; m < 4; ++m) { const size_t rb = (size_t)(row0 + ai * 128 + m * 16) * 512 + cb;
#pragma unroll
                        for (int bj = 0; bj < 2; ++bj) { f32x4 v0 = acc[ai][bj][m][0], v1 = acc[ai][bj][m][1];
                            if (type != 2) {
#pragma unroll
                                for (int j = 0; j < 4; ++j) { v0[j] = siluf_(v0[j]); v1[j] = siluf_(v1[j]); } }
                            u32x4 w; w.x = cvt_pk_bf16(v0[0], v0[1]); w.y = cvt_pk_bf16(v0[2], v0[3]); w.z = cvt_pk_bf16(v1[0], v1[1]); w.w = cvt_pk_bf16(v1[2], v1[3]);
                            *(u32x4*)(dst + rb + bj * 128) = w; } }
            }
        } else {
            const int cu = (pn - 8) * 128 + wc * 32 + 8 * fq;
#pragma unroll
            for (int ai = 0; ai < 2; ++ai)
#pragma unroll
                for (int m = 0; m < 4; ++m) { const int row = row0 + ai * 128 + m * 16;
                    f32x4 u0, u1;
#pragma unroll
                    for (int j = 0; j < 4; ++j) { u0[j] = acc[ai][0][m][0][j] * sigmoidf_(acc[ai][1][m][0][j]); u1[j] = acc[ai][0][m][1][j] * sigmoidf_(acc[ai][1][m][1][j]); }
                    u32x4 w; w.x = cvt_pk_bf16(u0[0], u0[1]); w.y = cvt_pk_bf16(u0[2], u0[3]); w.z = cvt_pk_bf16(u1[0], u1[1]); w.w = cvt_pk_bf16(u1[2], u1[3]);
                    *(u32x4*)(U + (size_t)row * 512 + cu) = w;
                    if (row < MP) { const int t = row & (SEQ - 1);
                        if (t >= SEQ - (CW - 1)) { float* o = scp + ((size_t)((row >> 11) * (CW - 1) + t - (SEQ - (CW - 1)))) * MIXB + cu; __builtin_nontemporal_store(u0, (f32x4*)o); __builtin_nontemporal_store(u1, (f32x4*)(o + 4)); }
                    } else { const int rs = row - MP; float* o = scs + ((size_t)((rs >> 2) * (CW - 1) + (CW - 1 - DS) + (rs & 3))) * MIXB + cu; *(f32x4*)o = u0; *(f32x4*)(o + 4) = u1; }
                }
        }
    }
    struct SPre { f32x4 l0, l1; };
    __device__ __forceinline__ void small_pre(int row, int c0p, int c1p, SPre& sp) const { const int c0 = permcol(c0p), c1 = permcol(c1p);
        if ((c0 >> 9) == 1) { sp.l0 = *(const f32x4*)(LB + (c0 & 511)); sp.l1 = *(const f32x4*)(LB + (c1 & 511)); } else { sp.l0 = (f32x4){0.f, 0.f, 0.f, 0.f}; sp.l1 = sp.l0; } }
    __device__ __forceinline__ void small(int row, int c0p, int c1p, const f32x4& v0, const f32x4& v1, const SPre& sp) const {
        const int c0 = permcol(c0p), c1 = permcol(c1p);
        if (c0 < 2048) { const int type = c0 >> 9;
#pragma unroll
            for (int gsel = 0; gsel < 2; ++gsel) { const int cs = (gsel ? c1 : c0) & 511; const f32x4 x = gsel ? v1 : v0; const size_t rb = (size_t)row * 512 + cs;
                if (type == 1) { const f32x4 lb = gsel ? sp.l1 : sp.l0; f32x4 lg; float kk[4];
#pragma unroll
                    for (int j = 0; j < 4; ++j) { kk[j] = (1.0f - lb[j]) * frcp(1.0f + __expf(x[j])); lg[j] = __log2f(1.0f - kk[j]); }
                    *(f32x4*)(LOGF + rb) = lg; u32x2 w; w.x = cvt_pk_bf16(kk[0], kk[1]); w.y = cvt_pk_bf16(kk[2], kk[3]); *(u32x2*)(Kk + rb) = w;
                } else { bf16_t* dst = Q + (size_t)type * ((size_t)MT * 512); f32x4 y = x;
                    if (type != 2) {
#pragma unroll
                        for (int j = 0; j < 4; ++j) y[j] = siluf_(y[j]); }
                    u32x2 w; w.x = cvt_pk_bf16(y[0], y[1]); w.y = cvt_pk_bf16(y[2], y[3]); *(u32x2*)(dst + rb) = w; } }
        } else { const int n1 = c0 - 2048, cu = (n1 >> 8) * 128 + (n1 & 127); f32x4 uu;
#pragma unroll
            for (int j = 0; j < 4; ++j) uu[j] = v0[j] * sigmoidf_(v1[j]);
            u32x2 w; w.x = cvt_pk_bf16(uu[0], uu[1]); w.y = cvt_pk_bf16(uu[2], uu[3]); *(u32x2*)(U + (size_t)row * 512 + cu) = w;
            const int rs = row - MP; __builtin_nontemporal_store(uu, (f32x4*)(scs + ((size_t)((rs >> 2) * (CW - 1) + (CW - 1 - DS) + (rs & 3))) * MIXB + cu)); }
    }
};
__device__ __forceinline__ void unpack8(const u32x4& w, f32x4& a, f32x4& b) {
    a[0] = __uint_as_float(w.x << 16); a[1] = __uint_as_float(w.x & 0xffff0000u); a[2] = __uint_as_float(w.y << 16); a[3] = __uint_as_float(w.y & 0xffff0000u);
    b[0] = __uint_as_float(w.z << 16); b[1] = __uint_as_float(w.z & 0xffff0000u); b[2] = __uint_as_float(w.w << 16); b[3] = __uint_as_float(w.w & 0xffff0000u); }
__device__ __forceinline__ f32x4 unpack4(const u32x2& w) { f32x4 a; a[0] = __uint_as_float(w.x << 16); a[1] = __uint_as_float(w.x & 0xffff0000u); a[2] = __uint_as_float(w.y << 16); a[3] = __uint_as_float(w.y & 0xffff0000u); return a; }
template <bool BASEBF>
struct EpiRes {
    static constexpr bool PERM = true;
    const float* base0; const float* base1; bf16_t* HB; float* sumsq; bf16_t* HBo;
    static constexpr int NPRE = 1;
    __device__ __forceinline__ void preload(const Unit&, int, int, float (&)[1]) const {}
    __device__ __forceinline__ void operator()(const f32x4 (&acc)[2][2][4][2], const Unit& u, int wr, int wc, int fr, int fq, const float (&epre)[1]) const {
        const int row0 = u.pm * 256 + wr * 64 + fr, col0 = u.pn * 256 + wc * 32 + 8 * fq;
#pragma unroll
        for (int ai = 0; ai < 2; ++ai) {
            float ssv[4];
            f32x4 bv[4][2][2];
#pragma unroll
            for (int m = 0; m < 4; ++m) { const int row = row0 + ai * 128 + m * 16;
#pragma unroll
                for (int bj = 0; bj < 2; ++bj) {
                    if (BASEBF) { unpack8(*(const u32x4*)(HB + (size_t)row * DM + col0 + bj * 128), bv[m][bj][0], bv[m][bj][1]); }
                    else { const float* bp = (row < MP ? base0 + (size_t)row * DM : base1 + (size_t)(row - MP) * DM) + col0 + bj * 128; bv[m][bj][0] = __builtin_nontemporal_load((const f32x4*)bp); bv[m][bj][1] = __builtin_nontemporal_load((const f32x4*)(bp + 4)); } } }
#pragma unroll
            for (int m = 0; m < 4; ++m) { const int row = row0 + ai * 128 + m * 16;
                float ss = 0.f;
#pragma unroll
                for (int bj = 0; bj < 2; ++bj) { const f32x4 h0 = bv[m][bj][0] + acc[ai][bj][m][0], h1 = bv[m][bj][1] + acc[ai][bj][m][1];
                    u32x4 w; w.x = cvt_pk_bf16(h0[0], h0[1]); w.y = cvt_pk_bf16(h0[2], h0[3]); w.z = cvt_pk_bf16(h1[0], h1[1]); w.w = cvt_pk_bf16(h1[2], h1[3]);
                    *(u32x4*)(HBo + (size_t)row * DM + col0 + bj * 128) = w;
                    ss += (h0[0] * h0[0] + h0[1] * h0[1]) + (h0[2] * h0[2] + h0[3] * h0[3]) + (h1[0] * h1[0] + h1[1] * h1[1]) + (h1[2] * h1[2] + h1[3] * h1[3]); }
                ssv[m] = ss;
            }
#pragma unroll
            for (int m = 0; m < 4; ++m) ssv[m] += __shfl_xor(ssv[m], 16);
#pragma unroll
            for (int m = 0; m < 4; ++m) ssv[m] += __shfl_xor(ssv[m], 32);
            if (fq == 0) {
#pragma unroll
                for (int m = 0; m < 4; ++m) atomicAdd(sumsq + row0 + ai * 128 + m * 16, ssv[m]); }
        }
    }
    struct SPre { f32x4 b0, b1; };
    __device__ __forceinline__ void small_pre(int row, int c0, int c1, SPre& sp) const {
        if (BASEBF) { sp.b0 = unpack4(*(const u32x2*)(HB + (size_t)row * DM + c0)); sp.b1 = unpack4(*(const u32x2*)(HB + (size_t)row * DM + c1)); }
        else { const float* bp = row < MP ? base0 + (size_t)row * DM : base1 + (size_t)(row - MP) * DM; sp.b0 = *(const f32x4*)(bp + c0); sp.b1 = *(const f32x4*)(bp + c1); } }
    __device__ __forceinline__ void small(int row, int c0, int c1, const f32x4& v0, const f32x4& v1, const SPre& sp) const {
        float ss = 0.f;
#pragma unroll
        for (int gsel = 0; gsel < 2; ++gsel) { const int c = gsel ? c1 : c0; bf16_t* hb = HB + (size_t)row * DM + c; f32x4 h;
            h = gsel ? sp.b1 : sp.b0;
            h += (gsel ? v1 : v0);
            u32x2 w; w.x = cvt_pk_bf16(h[0], h[1]); w.y = cvt_pk_bf16(h[2], h[3]); *(u32x2*)(HBo + (size_t)row * DM + c) = w;
            ss += (h[0] * h[0] + h[1] * h[1]) + (h[2] * h[2] + h[3] * h[3]); }
        ss = dpp_step<0x141>(dpp_step<0x4E>(dpp_step<0xB1>(ss)));
        if ((threadIdx.x & 7) == 0) atomicAdd(sumsq + row, ss);
    }
};
struct EpiSwi {
    static constexpr bool PERM = true;
    const float* sumsq; bf16_t* ACT;
    static constexpr int NPRE = 8;
    __device__ __forceinline__ void preload(const Unit& u, int wr, int fr, float (&pre)[8]) const { const int row0 = u.pm * 256 + wr * 64 + fr;
#pragma unroll
        for (int ai = 0; ai < 2; ++ai)
#pragma unroll
            for (int m = 0; m < 4; ++m) pre[ai * 4 + m] = sumsq[row0 + ai * 128 + m * 16]; }
    __device__ __forceinline__ void operator()(const f32x4 (&acc)[2][2][4][2], const Unit& u, int wr, int wc, int fr, int fq, const float (&epre)[8]) const {
        const int row0 = u.pm * 256 + wr * 64 + fr, col0 = u.pn * 128 + wc * 32 + 8 * fq;
#pragma unroll
        for (int ai = 0; ai < 2; ++ai)
#pragma unroll
            for (int m = 0; m < 4; ++m) { const int row = row0 + ai * 128 + m * 16;
                const float rstd = rsqrtf(epre[ai * 4 + m] * (1.0f / DM) + EPS), c1 = -1.44269504f * rstd, c2 = rstd * rstd;
                f32x4 av[2];
#pragma unroll
                for (int n = 0; n < 2; ++n) { const f32x4 g = acc[ai][0][m][n], t = g * c1; f32x4 e;
#pragma unroll
                    for (int j = 0; j < 4; ++j) e[j] = __builtin_amdgcn_exp2f(t[j]);
                    const f32x4 d = e + 1.0f; f32x4 r;
#pragma unroll
                    for (int j = 0; j < 4; ++j) r[j] = frcp(d[j]);
                    av[n] = (g * acc[ai][1][m][n]) * (r * c2); }
                u32x4 w; w.x = cvt_pk_bf16(av[0][0], av[0][1]); w.y = cvt_pk_bf16(av[0][2], av[0][3]); w.z = cvt_pk_bf16(av[1][0], av[1][1]); w.w = cvt_pk_bf16(av[1][2], av[1][3]);
                *(u32x4*)(ACT + (size_t)row * DFF + col0) = w; }
    }
};
struct EpiBf {
    static constexpr bool PERM = true;
    bf16_t* O;
    static constexpr int NPRE = 1;
    __device__ __forceinline__ void preload(const Unit&, int, int, float (&)[1]) const {}
    __device__ __forceinline__ void operator()(const f32x4 (&acc)[2][2][4][2], const Unit& u, int wr, int wc, int fr, int fq, const float (&epre)[1]) const {
        const int row0 = u.pm * 256 + wr * 64 + fr, col0 = u.pn * 256 + wc * 32 + 8 * fq;
#pragma unroll
        for (int ai = 0; ai < 2; ++ai)
#pragma unroll
            for (int m = 0; m < 4; ++m)
#pragma unroll
                for (int bj = 0; bj < 2; ++bj) { const f32x4 v0 = acc[ai][bj][m][0], v1 = acc[ai][bj][m][1];
                    u32x4 w; w.x = cvt_pk_bf16(v0[0], v0[1]); w.y = cvt_pk_bf16(v0[2], v0[3]); w.z = cvt_pk_bf16(v1[0], v1[1]); w.w = cvt_pk_bf16(v1[2], v1[3]);
                    *(u32x4*)(O + (size_t)(row0 + ai * 128 + m * 16) * DM + col0 + bj * 128) = w; }
    }
    struct SPre { int dummy; };
    __device__ __forceinline__ void small_pre(int, int, int, SPre& sp) const { sp.dummy = 0; }
    __device__ __forceinline__ void small(int row, int c0, int c1, const f32x4& v0, const f32x4& v1, const SPre& sp) const {
        u32x2 w; w.x = cvt_pk_bf16(v0[0], v0[1]); w.y = cvt_pk_bf16(v0[2], v0[3]); *(u32x2*)(O + (size_t)row * DM + c0) = w;
        w.x = cvt_pk_bf16(v1[0], v1[1]); w.y = cvt_pk_bf16(v1[2], v1[3]); *(u32x2*)(O + (size_t)row * DM + c1) = w;
    }
};
struct EpiPle {
    static constexpr bool PERM = true;
    const float* sumsq2; const bf16_t* PPb; const bf16_t* HB; bf16_t* H3; float* sumsq3;
    static constexpr int NPRE = 8;
    __device__ __forceinline__ void preload(const Unit& u, int wr, int fr, float (&pre)[8]) const { const int row0 = u.pm * 256 + wr * 64 + fr;
#pragma unroll
        for (int ai = 0; ai < 2; ++ai)
#pragma unroll
            for (int m = 0; m < 4; ++m) pre[ai * 4 + m] = sumsq2[row0 + ai * 128 + m * 16]; }
    __device__ __forceinline__ void operator()(const f32x4 (&acc)[2][2][4][2], const Unit& u, int wr, int wc, int fr, int fq, const float (&epre)[8]) const {
        const int row0 = u.pm * 256 + wr * 64 + fr, col0 = u.pn * 256 + wc * 32 + 8 * fq;
#pragma unroll
        for (int ai = 0; ai < 2; ++ai) {
            float ssv[4];
            u32x4 hw[4][2], pw[4][2];
#pragma unroll
            for (int m = 0; m < 4; ++m)
#pragma unroll
                for (int bj = 0; bj < 2; ++bj) { const size_t o = (size_t)(row0 + ai * 128 + m * 16) * DM + col0 + bj * 128; hw[m][bj] = *(const u32x4*)(HB + o); pw[m][bj] = *(const u32x4*)(PPb + o); }
#pragma unroll
            for (int m = 0; m < 4; ++m) { const int row = row0 + ai * 128 + m * 16;
                const float rstd = rsqrtf(epre[ai * 4 + m] * (1.0f / DM) + EPS);
                float ss = 0.f;
#pragma unroll
                for (int bj = 0; bj < 2; ++bj) { const size_t o = (size_t)row * DM + col0 + bj * 128;
                    f32x4 h0, h1, p0, p1; unpack8(hw[m][bj], h0, h1); unpack8(pw[m][bj], p0, p1);
#pragma unroll
                    for (int j = 0; j < 4; ++j) { h0[j] += sigmoidf_(acc[ai][bj][m][0][j] * rstd) * p0[j]; h1[j] += sigmoidf_(acc[ai][bj][m][1][j] * rstd) * p1[j]; }
                    u32x4 w; w.x = cvt_pk_bf16(h0[0], h0[1]); w.y = cvt_pk_bf16(h0[2], h0[3]); w.z = cvt_pk_bf16(h1[0], h1[1]); w.w = cvt_pk_bf16(h1[2], h1[3]);
                    *(u32x4*)(H3 + o) = w;
                    ss += (h0[0] * h0[0] + h0[1] * h0[1]) + (h0[2] * h0[2] + h0[3] * h0[3]) + (h1[0] * h1[0] + h1[1] * h1[1]) + (h1[2] * h1[2] + h1[3] * h1[3]); }
                ssv[m] = ss;
            }
#pragma unroll
            for (int m = 0; m < 4; ++m) ssv[m] += __shfl_xor(ssv[m], 16);
#pragma unroll
            for (int m = 0; m < 4; ++m) ssv[m] += __shfl_xor(ssv[m], 32);
            if (fq == 0) {
#pragma unroll
                for (int m = 0; m < 4; ++m) atomicAdd(sumsq3 + row0 + ai * 128 + m * 16, ssv[m]); }
        }
    }
    struct SPre { f32x4 h0, h1; float ss; };
    __device__ __forceinline__ void small_pre(int row, int c0, int c1, SPre& sp) const { sp.ss = sumsq2[row]; sp.h0 = unpack4(*(const u32x2*)(HB + (size_t)row * DM + c0)); sp.h1 = unpack4(*(const u32x2*)(HB + (size_t)row * DM + c1)); }
    __device__ __forceinline__ void small(int row, int c0, int c1, const f32x4& v0, const f32x4& v1, const SPre& sp) const {
        const float rstd = rsqrtf(sp.ss * (1.0f / DM) + EPS); float ss = 0.f;
#pragma unroll
        for (int gsel = 0; gsel < 2; ++gsel) { const int c = gsel ? c1 : c0; const f32x4 x = gsel ? v1 : v0; const size_t o = (size_t)row * DM + c;
            f32x4 h = gsel ? sp.h1 : sp.h0; const f32x4 pp = unpack4(*(const u32x2*)(PPb + o));
#pragma unroll
            for (int j = 0; j < 4; ++j) h[j] += sigmoidf_(x[j] * rstd) * pp[j];
            u32x2 w; w.x = cvt_pk_bf16(h[0], h[1]); w.y = cvt_pk_bf16(h[2], h[3]); *(u32x2*)(H3 + o) = w;
            ss += (h[0] * h[0] + h[1] * h[1]) + (h[2] * h[2] + h[3] * h[3]); }
        ss = dpp_step<0x141>(dpp_step<0x4E>(dpp_step<0xB1>(ss)));
        if ((threadIdx.x & 7) == 0) atomicAdd(sumsq3 + row, ss);
    }
};

struct OrderFfn {
    pg8::StaticOrder so; int nsamp, nN;
    __device__ void init(int G, int c) { so.init(MP, 2 * DFF, G, c); nN = 2 * DFF / 256; nsamp = (MS / 256) * nN; }
    __device__ bool next(int i, Unit& u) const { const long L = (long)i * so.G + so.c;
        if (L < so.nwg) return so.next(i, u);
        const int e = (int)(L - so.nwg); if (e >= nsamp) return false; u.pm = MP / 256 + e / nN; u.pn = e % nN; return true; }
    __device__ __forceinline__ void a_ready(const Unit&) const {}
    __device__ __forceinline__ void done(const Unit&) const {}
};

struct TrItem { const float* W; const float* gain; bf16_t* WT; int ldw, K, sc0, dr0, kb; };
__device__ __forceinline__ void tr_decode(const Params& p, int r, TrItem& t) {
    constexpr int I1 = (DM / 64) * (DIN / 32), I2 = (DM / 64) * (DM / 32), I3 = (DM / 64) * (2 * DFF / 32), I4 = (DFF / 64) * (DM / 32), I5 = I2;
    unsigned char* ws = p.ws; t.gain = nullptr;
    if (r < I1) { const int nb = r % (DIN / 32), n0p = nb * 32, n0 = permcol(n0p); t.kb = r / (DIN / 32);
        if (n0 < 2048) t.sc0 = n0; else { const int n1 = n0 - 2048, tt = n1 >> 8, w = n1 & 255; t.sc0 = 2048 + (w >> 7) * 512 + tt * 128 + (w & 127); }
        t.W = p.in[I_WIN]; t.ldw = DIN; t.K = DM; t.WT = (bf16_t*)(ws + WS_W1); t.dr0 = n0p; return; } r -= I1;
    if (r < I2) { const int nb = r % (DM / 32); t.kb = r / (DM / 32); t.W = p.in[I_WOUT]; t.ldw = DM; t.K = DM; t.sc0 = nb * 32; t.WT = (bf16_t*)(ws + WS_W2); t.dr0 = nb * 32; return; } r -= I2;
    if (r < I3) { const int nb = r % (2 * DFF / 32), n0 = nb * 32, tt = n0 >> 8, w = n0 & 255; t.kb = r / (2 * DFF / 32);
        t.W = (w >> 7) ? p.in[I_WU] : p.in[I_WG]; t.ldw = DFF; t.K = DM; t.sc0 = tt * 128 + (w & 127); t.gain = p.in[I_NFFN]; t.WT = (bf16_t*)(ws + WS_W3); t.dr0 = n0; return; } r -= I3;
    if (r < I4) { const int nb = r % (DM / 32); t.kb = r / (DM / 32); t.W = p.in[I_WD]; t.ldw = DM; t.K = DFF; t.sc0 = nb * 32; t.WT = (bf16_t*)(ws + WS_W4); t.dr0 = nb * 32; return; } r -= I4;
    if (r < I5) { const int nb = r % (DM / 32); t.kb = r / (DM / 32); t.W = p.in[I_WPG]; t.ldw = DM; t.K = DM; t.sc0 = nb * 32; t.gain = p.in[I_NPLE]; t.WT = (bf16_t*)(ws + WS_W5); t.dr0 = nb * 32; return; } r -= I5;
    { const int nb = r % (DM / 32); t.kb = r / (DM / 32); t.W = p.in[I_WPP]; t.ldw = DM; t.K = DPLE; t.sc0 = nb * 32; t.WT = (bf16_t*)(ws + WS_W6); t.dr0 = nb * 32; }
}
__device__ __forceinline__ void tr_load(const TrItem& t, int lane, f32x4 (&v)[8], f32x4 (&g)[2]) {
    const int r = lane & 7, k0 = 64 * t.kb + 8 * (lane >> 3); const float* src = t.W + (size_t)k0 * t.ldw + t.sc0 + 4 * r;
#pragma unroll
    for (int i = 0; i < 8; ++i) v[i] = __builtin_nontemporal_load((const f32x4*)(src + (size_t)i * t.ldw));
    if (t.gain) { g[0] = *(const f32x4*)(t.gain + k0); g[1] = *(const f32x4*)(t.gain + k0 + 4); } else { g[0] = (f32x4){1.f, 1.f, 1.f, 1.f}; g[1] = g[0]; }
}
__device__ __forceinline__ void tr_store(const TrItem& t, int lane, const f32x4 (&v)[8], const f32x4 (&g)[2]) {
    const int r = lane & 7, k0 = 64 * t.kb + 8 * (lane >> 3); bf16_t* dst = t.WT + (size_t)(t.dr0 + 4 * r) * t.K + k0;
#pragma unroll
    for (int j = 0; j < 4; ++j) { u32x4 o; o.x = cvt_pk_bf16(v[0][j] * g[0][0], v[1][j] * g[0][1]); o.y = cvt_pk_bf16(v[2][j] * g[0][2], v[3][j] * g[0][3]);
        o.z = cvt_pk_bf16(v[4][j] * g[1][0], v[5][j] * g[1][1]); o.w = cvt_pk_bf16(v[6][j] * g[1][2], v[7][j] * g[1][3]); *(u32x4*)(dst + (size_t)j * t.K) = o; }
}

__device__ __forceinline__ void p0_prologue(const Params& p, unsigned char* lds) {
    const int tid = threadIdx.x, lane = tid & 63, wave = tid >> 6, G = gridDim.x;
    const int gw = blockIdx.x * 8 + wave, NGW = G * 8;
    unsigned char* ws = p.ws;
    constexpr int NITEMS = (DM / 64) * (DIN / 32) + 2 * (DM / 64) * (DM / 32) + (DM / 64) * (2 * DFF / 32) + (DFF / 64) * (DM / 32) + (DPLE / 64) * (DM / 32);
    for (int it = gw; it < NITEMS; it += 2 * NGW) {
        const int it1 = it + NGW < NITEMS ? it + NGW : it;
        TrItem t0, t1; tr_decode(p, it, t0); tr_decode(p, it1, t1);
        f32x4 v0[8], v1[8], g0[2], g1[2];
        tr_load(t0, lane, v0, g0); tr_load(t1, lane, v1, g1);
        tr_store(t0, lane, v0, g0); tr_store(t1, lane, v1, g1);
    }
    {
        const f32x4* gp = (const f32x4*)p.in[I_NMIX] + lane; f32x4 gv[4];
#pragma unroll
        for (int j = 0; j < 4; ++j) gv[j] = gp[64 * j];
        bf16_t* XN = (bf16_t*)(ws + WS_XN);
        for (int m0 = 4 * gw; m0 < MT; m0 += 4 * NGW) {
            int mm[4]; const float* xr[4];
#pragma unroll
            for (int q = 0; q < 4; ++q) { mm[q] = m0 + q;
                xr[q] = mm[q] < MP ? p.in[I_XP] + (size_t)mm[q] * DM : p.in[I_XS] + (size_t)(mm[q] - MP) * DM; }
            f32x4 v[4][4];
#pragma unroll
            for (int q = 0; q < 4; ++q)
#pragma unroll
                for (int j = 0; j < 4; ++j) v[q][j] = __builtin_nontemporal_load((const f32x4*)xr[q] + lane + 64 * j);
#pragma unroll
            for (int q = 0; q < 4; ++q) { float s = 0.f;
#pragma unroll
                for (int j = 0; j < 4; ++j) s += (v[q][j][0] * v[q][j][0] + v[q][j][1] * v[q][j][1]) + (v[q][j][2] * v[q][j][2] + v[q][j][3] * v[q][j][3]);
                const float rstd = rsqrtf(wave_sum(s) * (1.0f / DM) + EPS);
                u32x2* o8 = (u32x2*)(XN + (size_t)mm[q] * DM) + lane;
#pragma unroll
                for (int j = 0; j < 4; ++j) { u32x2 o; o.x = cvt_pk_bf16(v[q][j][0] * rstd * gv[j][0], v[q][j][1] * rstd * gv[j][1]); o.y = cvt_pk_bf16(v[q][j][2] * rstd * gv[j][2], v[q][j][3] * rstd * gv[j][3]); o8[64 * j] = o; } }
        }
    }
    const size_t gt = (size_t)blockIdx.x * 512 + tid, NT = (size_t)G * 512;
    { bf16_t* PB = (bf16_t*)(ws + WS_PB); constexpr size_t NPB = (size_t)MT * DPLE / 8;
      for (size_t i0 = gt; i0 < NPB; i0 += 4 * NT) { f32x4 a[4], b[4]; size_t e[4];
#pragma unroll
          for (int q = 0; q < 4; ++q) { const size_t i = i0 + q * NT < NPB ? i0 + q * NT : i0; e[q] = i * 8; const float* s = e[q] < (size_t)MP * DPLE ? p.in[I_PP] + e[q] : p.in[I_PS] + (e[q] - (size_t)MP * DPLE);
              a[q] = __builtin_nontemporal_load((const f32x4*)s); b[q] = __builtin_nontemporal_load((const f32x4*)(s + 4)); }
#pragma unroll
          for (int q = 0; q < 4; ++q) { u32x4 w; w.x = cvt_pk_bf16(a[q][0], a[q][1]); w.y = cvt_pk_bf16(a[q][2], a[q][3]); w.z = cvt_pk_bf16(b[q][0], b[q][1]); w.w = cvt_pk_bf16(b[q][2], b[q][3]); *(u32x4*)(PB + e[q]) = w; } } }
    { float* z = (float*)(ws + WS_SS1); for (size_t i = gt; i < (WS_PB - WS_SS1) / 4; i += NT) z[i] = 0.f; }
    if (gt < MIXA) { const float l0 = p.in[I_LBL][gt], l1 = p.in[I_LBL][MIXA + gt]; ((float*)(ws + WS_LB))[gt] = 1.0f / (1.0f + expf(l1 - l0)); }
    { float* scs = p.out + O_SCS; const float* sc = p.in[I_SC]; constexpr int RW = (CW - 1 - DS) * MIXB / 4; constexpr size_t NCP = (size_t)DB * RW;
      for (size_t i0 = gt; i0 < NCP; i0 += 4 * NT) { f32x4 v[4]; size_t d[4];
#pragma unroll
          for (int q = 0; q < 4; ++q) { const size_t i = i0 + q * NT < NCP ? i0 + q * NT : i0, n = i / RW, w = i % RW; d[q] = n * (CW - 1) * MIXB + w * 4; v[q] = __builtin_nontemporal_load((const f32x4*)(sc + d[q] + DS * MIXB)); }
#pragma unroll
          for (int q = 0; q < 4; ++q) __builtin_nontemporal_store(v[q], (f32x4*)(scs + d[q])); } }
}

__device__ __forceinline__ void hgrn_sample_pair(const Params& p, float* lds, int unit) {
    int tid = threadIdx.x; asm volatile("" : "+v"(tid));
    const int half = tid >> 8, v = tid & 127, kg = (tid >> 7) & 1, lane = tid & 63, wq = (tid >> 6) & 3;
    unsigned char* ws = p.ws;
    const bf16_t* Q = (const bf16_t*)(ws + WS_Q); const bf16_t* Kk = (const bf16_t*)(ws + WS_K); const bf16_t* V = (const bf16_t*)(ws + WS_V); const bf16_t* Gt = (const bf16_t*)(ws + WS_G);
    const float* LOGF = (const float*)(ws + WS_LOGF); bf16_t* CAT = (bf16_t*)(ws + WS_CAT);
    const int n = unit >> 2, h = unit & 3, rowbase = MP + n * DS;
    float* sq = lds + half * 3072; float* sk = sq + 512; float* sf = sq + 1024; float* sv = sq + 1536; float* po = sq + 2048;
    float S[64]; float gn0 = 0.f, gn1 = 0.f, gt0 = 0.f, gt1 = 0.f;
    if (unit >= 0) {
        { const size_t g = (size_t)(rowbase + wq) * 512 + h * 128; gn0 = p.in[I_HON][lane]; gn1 = p.in[I_HON][lane + 64]; gt0 = bf2f(Gt[g + lane]); gt1 = bf2f(Gt[g + lane + 64]); }
        const float* s0 = p.in[I_SH] + ((size_t)(n * HEADS + h) * DK) * DV + (size_t)(64 * kg) * DV + v;
#pragma unroll
        for (int k = 0; k < 64; ++k) S[k] = __builtin_nontemporal_load(s0 + (size_t)k * DV);
#pragma unroll
        for (int i = 0; i < 2; ++i) { const int idx = (tid & 255) + 256 * i, t = idx >> 7, c = idx & 127; const size_t g = (size_t)(rowbase + t) * 512 + h * 128 + c;
            sq[idx] = bf2f(Q[g]); sk[idx] = bf2f(Kk[g]); sf[idx] = __builtin_amdgcn_exp2f(LOGF[g]); sv[idx] = bf2f(V[g]); }
    }
    LDS_BARRIER();
    if (unit >= 0) {
#pragma unroll
        for (int t = 0; t < DS; ++t) { const float vt = sv[t * 128 + v]; float o = 0.f; const float* f_ = sf + t * 128 + 64 * kg; const float* k_ = sk + t * 128 + 64 * kg; const float* q_ = sq + t * 128 + 64 * kg;
#pragma unroll
            for (int k = 0; k < 64; ++k) { S[k] = f_[k] * S[k] + k_[k] * vt; o += q_[k] * S[k]; }
            po[(t * 2 + kg) * 128 + v] = o; }
        float* so = p.out + O_SHS + ((size_t)(n * HEADS + h) * DK) * DV + (size_t)(64 * kg) * DV + v;
#pragma unroll
        for (int k = 0; k < 64; ++k) __builtin_nontemporal_store(S[k], so + (size_t)k * DV);
    }
    LDS_BARRIER();
    if (unit >= 0) { const int t = wq; const float* pp = po + (t * 2) * 128;
        const float a = pp[lane] + pp[128 + lane], b = pp[lane + 64] + pp[128 + lane + 64];
        const float rstd = rsqrtf(wave_sum(a * a + b * b) * (1.0f / DV) + EPS); const int row = rowbase + t; const size_t g = (size_t)row * 512 + h * 128;
        CAT[(size_t)row * DM + h * 128 + lane] = f2bf(a * rstd * gn0 * gt0); CAT[(size_t)row * DM + h * 128 + lane + 64] = f2bf(b * rstd * gn1 * gt1); }
    LDS_BARRIER();
}

__device__ __forceinline__ bf16x8 pack8(const f32x16& x, int s) {
    u32x4 q; q.x = pk2(x[8 * s], x[8 * s + 1]); q.y = pk2(x[8 * s + 2], x[8 * s + 3]); q.z = pk2(x[8 * s + 4], x[8 * s + 5]); q.w = pk2(x[8 * s + 6], x[8 * s + 7]); return __builtin_bit_cast(bf16x8, q); }
constexpr int QP = 136, TP = 40;
constexpr int HB_QD = 0, HB_KI = 32 * QP * 2, HB_KD = 2 * HB_KI, HB_VT = HB_KD + 128 * TP * 2, HB_DV = HB_VT + 128 * TP * 2, HB_SZ = HB_DV + 512, H_P = 2 * HB_SZ;
constexpr int H_PSZ = 2 * 32 * 128 * 4, LDS_MAIN = (H_P + 2 * H_PSZ) > pg8::STAGE_BYTES ? (H_P + 2 * H_PSZ) : pg8::STAGE_BYTES;

template <bool FULL>
__device__ __forceinline__ void hgrn_seg(const Params& p, unsigned char* lds, int b, int h, int seg) {
    const int tid = threadIdx.x, lane = tid & 63, w = __builtin_amdgcn_readfirstlane(tid >> 6);
    const int pk = 16 * w + (lane & 15), tg = lane >> 4;
    const int vb = w & 3, kh = w >> 2, r = lane & 31, hh = lane >> 5;
    unsigned char* ws = p.ws;
    const bf16_t* Q = (const bf16_t*)(ws + WS_Q); const bf16_t* Kk = (const bf16_t*)(ws + WS_K); const bf16_t* V = (const bf16_t*)(ws + WS_V); const bf16_t* Gt = (const bf16_t*)(ws + WS_G);
    const float* LOGF = (const float*)(ws + WS_LOGF); bf16_t* CAT = (bf16_t*)(ws + WS_CAT);
    float* SLOC = (float*)(ws + WS_SLOC); float* SDEC = (float*)(ws + WS_SDEC);
    const int row0 = b * SEQ + seg * SEGL, bh = b * HEADS + h;
    f32x16 S[2];
#pragma unroll
    for (int a = 0; a < 2; ++a)
#pragma unroll
        for (int i = 0; i < 16; ++i) S[a][i] = 0.f;
    if (FULL && seg > 0) {
        float* dl = (float*)(lds + H_P);
        for (int idx = tid; idx < seg * DK; idx += 512) dl[idx] = SDEC[(size_t)bh * NSEG * DK + idx];
        LDS_BARRIER();
        const float* sl0 = SLOC + (size_t)bh * NSEG * DK * DV + (size_t)(w * 8 * 64 + lane) * 4;
#pragma unroll 2
        for (int j = 0; j < seg; ++j) { const float* sl = sl0 + (size_t)j * DK * DV; const float* dj = dl + j * DK + 64 * kh + 4 * hh;
#pragma unroll
            for (int a = 0; a < 2; ++a)
#pragma unroll
                for (int g = 0; g < 4; ++g) { const f32x4 d4 = *(const f32x4*)(dj + 32 * a + 8 * g), s4 = *(const f32x4*)(sl + (a * 4 + g) * 256);
#pragma unroll
                    for (int i = 0; i < 4; ++i) S[a][4 * g + i] = d4[i] * S[a][4 * g + i] + s4[i]; } }
        LDS_BARRIER();
    }
    float bseg = 0.f;
    float lf[8]; unsigned kq[8], qq[8], vv[8], gq[8];
    const float gn0 = p.in[I_HON][lane], gn1 = p.in[I_HON][lane + 64];
#define HG_LOAD(c) do { const size_t g0 = (size_t)(row0 + (c) * 32 + 8 * tg) * 512 + h * 128 + pk; \
        _Pragma("unroll") for (int i = 0; i < 8; ++i) { lf[i] = LOGF[g0 + (size_t)i * 512]; kq[i] = Kk[g0 + (size_t)i * 512]; vv[i] = V[g0 + (size_t)i * 512]; if (FULL) qq[i] = Q[g0 + (size_t)i * 512]; } \
        if (FULL) { _Pragma("unroll") for (int tt = 0; tt < 4; ++tt) { const size_t g1 = (size_t)(row0 + (c) * 32 + 4 * w + tt) * 512 + h * 128; gq[2 * tt] = Gt[g1 + lane]; gq[2 * tt + 1] = Gt[g1 + lane + 64]; } } } while (0)
    float gprev[8];
#pragma unroll
    for (int i = 0; i < 8; ++i) gprev[i] = 0.f;
#define HG_FINALIZE(cc) do { const float* P0 = (const float*)(lds + H_P + ((cc) & 1) * H_PSZ); const float* P1 = P0 + 4096; \
        _Pragma("unroll") for (int tt = 0; tt < 4; ++tt) { const int t = 4 * w + tt; const float a = P0[t * 128 + lane] + P1[t * 128 + lane], b2 = P0[t * 128 + lane + 64] + P1[t * 128 + lane + 64]; \
            const float rstd = rsqrtf(wave_sum(a * a + b2 * b2) * (1.0f / DV) + EPS); const size_t orow = (size_t)(row0 + (cc) * 32 + t) * DM + h * 128; \
            CAT[orow + lane] = f2bf(a * rstd * gn0 * gprev[2 * tt]); CAT[orow + lane + 64] = f2bf(b2 * rstd * gn1 * gprev[2 * tt + 1]); } } while (0)
    HG_LOAD(0);
    for (int c = 0; c < NCH; ++c) {
        unsigned char* buf = lds + (c & 1) * HB_SZ;
        {
            float bl[8]; float run = 0.f;
#pragma unroll
            for (int i = 0; i < 8; ++i) { run += lf[i]; bl[i] = run; }
            const int kk = lane & 15;
            const float t0 = __shfl(run, kk), t1 = __shfl(run, kk + 16), t2 = __shfl(run, kk + 32), t3 = __shfl(run, kk + 48);
            const float off = (tg > 0 ? t0 : 0.f) + (tg > 1 ? t1 : 0.f) + (tg > 2 ? t2 : 0.f);
            const float blast = (t0 + t1) + (t2 + t3), dd = __builtin_amdgcn_exp2f(blast);
            bseg += blast;
            float kd[8];
#pragma unroll
            for (int i = 0; i < 8; ++i) { const float eb = __builtin_amdgcn_exp2f(bl[i] + off), einv = frcp(eb), kf = __uint_as_float(kq[i] << 16);
                kd[i] = kf * (dd * einv);
                if (FULL) { *(bf16_t*)(buf + HB_QD + ((8 * tg + i) * QP + pk) * 2) = (bf16_t)(pk2(__uint_as_float(qq[i] << 16) * eb, 0.f) & 0xffffu); *(bf16_t*)(buf + HB_KI + ((8 * tg + i) * QP + pk) * 2) = (bf16_t)(pk2(kf * einv, 0.f) & 0xffffu); } }
            u32x4 kw; kw.x = pk2(kd[0], kd[1]); kw.y = pk2(kd[2], kd[3]); kw.z = pk2(kd[4], kd[5]); kw.w = pk2(kd[6], kd[7]);
            *(u32x4*)(buf + HB_KD + (pk * TP + 8 * tg) * 2) = kw;
            u32x4 vw; vw.x = vv[0] | (vv[1] << 16); vw.y = vv[2] | (vv[3] << 16); vw.z = vv[4] | (vv[5] << 16); vw.w = vv[6] | (vv[7] << 16);
            *(u32x4*)(buf + HB_VT + (pk * TP + 8 * tg) * 2) = vw;
            if (tg == 0) *(float*)(buf + HB_DV + pk * 4) = dd;
        }
        float gnew[8];
        if (FULL) {
#pragma unroll
            for (int i = 0; i < 8; ++i) gnew[i] = __uint_as_float(gq[i] << 16); }
        { const int cn = c + 1 < NCH ? c + 1 : c; HG_LOAD(cn); }
        LDS_BARRIER();
        if (FULL && c > 0) HG_FINALIZE(c - 1);
        const unsigned char* qd = buf + HB_QD; const unsigned char* ki = buf + HB_KI; const unsigned char* kdt = buf + HB_KD; const unsigned char* vt = buf + HB_VT; const unsigned char* dv = buf + HB_DV;
        if (FULL) {
            f32x16 sc;
#pragma unroll
            for (int i = 0; i < 16; ++i) sc[i] = 0.f;
            bf16x8 ka[4], qa[4];
#pragma unroll
            for (int st = 0; st < 4; ++st) { const int kc = 64 * kh + 16 * st + 8 * hh; ka[st] = *(const bf16x8*)(ki + (r * QP + kc) * 2); qa[st] = *(const bf16x8*)(qd + (r * QP + kc) * 2); }
            bf16x8 vi[2], qb[2][2];
#pragma unroll
            for (int s = 0; s < 2; ++s) { const s16x4 lo = *(const s16x4*)(vt + ((32 * vb + r) * TP + 16 * s + 4 * hh) * 2), hi = *(const s16x4*)(vt + ((32 * vb + r) * TP + 16 * s + 8 + 4 * hh) * 2);
                vi[s] = (bf16x8){lo[0], lo[1], lo[2], lo[3], hi[0], hi[1], hi[2], hi[3]}; }
#pragma unroll
            for (int a2 = 0; a2 < 2; ++a2)
#pragma unroll
                for (int s = 0; s < 2; ++s) { const int kc = 32 * (2 * kh + a2) + 16 * s + 4 * hh;
                    const s16x4 lo = *(const s16x4*)(qd + (r * QP + kc) * 2), hi = *(const s16x4*)(qd + (r * QP + kc + 8) * 2); qb[a2][s] = (bf16x8){lo[0], lo[1], lo[2], lo[3], hi[0], hi[1], hi[2], hi[3]}; }
#pragma unroll
            for (int st = 0; st < 4; ++st) sc = HG_MFMA(ka[st], qa[st], sc);
#pragma unroll
            for (int g = 0; g < 4; ++g)
#pragma unroll
                for (int i = 0; i < 4; ++i) if (8 * g + 4 * hh + i > r) sc[4 * g + i] = 0.f;
            f32x16 oacc;
#pragma unroll
            for (int i = 0; i < 16; ++i) oacc[i] = 0.f;
#pragma unroll
            for (int s = 0; s < 2; ++s) { const bf16x8 a = pack8(sc, s); oacc = HG_MFMA(a, vi[s], oacc); }
#pragma unroll
            for (int a2 = 0; a2 < 2; ++a2)
#pragma unroll
                for (int s = 0; s < 2; ++s) { const bf16x8 bS = pack8(S[a2], s); oacc = HG_MFMA(qb[a2][s], bS, oacc); }
            float* P = (float*)(lds + H_P + (c & 1) * H_PSZ) + kh * 4096;
#pragma unroll
            for (int g = 0; g < 4; ++g)
#pragma unroll
                for (int i = 0; i < 4; ++i) P[(8 * g + 4 * hh + i) * 128 + 32 * vb + r] = oacc[4 * g + i];
        }
        { bf16x8 da[2][2], db[2]; f32x4 dd4[2][4];
#pragma unroll
          for (int s = 0; s < 2; ++s) db[s] = *(const bf16x8*)(vt + ((32 * vb + r) * TP + 16 * s + 8 * hh) * 2);
#pragma unroll
          for (int a2 = 0; a2 < 2; ++a2) { const int kt = 2 * kh + a2;
#pragma unroll
              for (int s = 0; s < 2; ++s) da[a2][s] = *(const bf16x8*)(kdt + ((32 * kt + r) * TP + 16 * s + 8 * hh) * 2);
#pragma unroll
              for (int g = 0; g < 4; ++g) dd4[a2][g] = *(const f32x4*)(dv + (32 * kt + 8 * g + 4 * hh) * 4); }
#pragma unroll
          for (int a2 = 0; a2 < 2; ++a2) {
#pragma unroll
              for (int g = 0; g < 4; ++g)
#pragma unroll
                  for (int i = 0; i < 4; ++i) S[a2][4 * g + i] *= dd4[a2][g][i];
#pragma unroll
              for (int s = 0; s < 2; ++s) S[a2] = HG_MFMA(da[a2][s], db[s], S[a2]); } }
        if (FULL) {
#pragma unroll
            for (int i = 0; i < 8; ++i) gprev[i] = gnew[i]; }
    }
    if (FULL) { LDS_BARRIER(); HG_FINALIZE(NCH - 1); }
#undef HG_FINALIZE
#undef HG_LOAD
    if (FULL) { if (seg == NSEG - 1) { float* so = p.out + O_SHP + (size_t)bh * DK * DV;
#pragma unroll
        for (int a = 0; a < 2; ++a)
#pragma unroll
            for (int g = 0; g < 4; ++g)
#pragma unroll
                for (int i = 0; i < 4; ++i) so[(size_t)(32 * (2 * kh + a) + 8 * g + 4 * hh + i) * DV + 32 * vb + r] = S[a][4 * g + i]; }
    } else { float* so = SLOC + (size_t)(bh * NSEG + seg) * DK * DV + (size_t)(w * 8 * 64 + lane) * 4;
#pragma unroll
        for (int a = 0; a < 2; ++a)
#pragma unroll
            for (int g = 0; g < 4; ++g) *(f32x4*)(so + (a * 4 + g) * 256) = (f32x4){S[a][4 * g], S[a][4 * g + 1], S[a][4 * g + 2], S[a][4 * g + 3]}; }
    if (!FULL && tg == 0) SDEC[(size_t)(bh * NSEG + seg) * DK + pk] = __builtin_amdgcn_exp2f(bseg);
    LDS_BARRIER();
}

template <int TT>
__device__ __forceinline__ void conv_pair(const Params& p, unsigned char* lds, bool sample, int tile) {
    int tid = threadIdx.x; asm volatile("" : "+v"(tid));
    const int half = tid >> 8, cp = tid & 255, lane = tid & 63, wq = (tid >> 6) & 3;
    unsigned char* ws = p.ws; const bf16_t* U = (const bf16_t*)(ws + WS_U); bf16_t* CAT = (bf16_t*)(ws + WS_CAT);
    const int sq = sample ? tile : tile >> 7, t0 = sample ? 0 : (tile & 127) * 16;
    const int row0 = sample ? MP + sq * DS : sq * SEQ + t0;
    float* zb = (float*)lds + (size_t)half * (TT * MIXB);
    const f32x4 g0 = *(const f32x4*)(p.in[I_CLG] + 8 * lane), g1 = *(const f32x4*)(p.in[I_CLG] + 8 * lane + 4), b0 = *(const f32x4*)(p.in[I_CLB] + 8 * lane), b1 = *(const f32x4*)(p.in[I_CLB] + 8 * lane + 4);
    if (tile >= 0) {
        f32x2v w[CW];
#pragma unroll
        for (int j = 0; j < CW; ++j) w[j] = *(const f32x2v*)(p.in[I_CDW] + j * MIXB + 2 * cp);
        const f32x2v bias = *(const f32x2v*)(p.in[I_CDB] + 2 * cp);
        f32x2v acc[TT];
#pragma unroll
        for (int t = 0; t < TT; ++t) acc[t] = bias;
#pragma unroll
        for (int r = 0; r < TT + CW - 1; ++r) {
            f32x2v val;
            if (sample && r < CW - 1) val = __builtin_nontemporal_load((const f32x2v*)(p.in[I_SC] + ((size_t)sq * (CW - 1) + r) * MIXB + 2 * cp));
            else { const int i = t0 + r - (CW - 1); unsigned raw = 0u; if (sample || i >= 0) raw = *(const unsigned*)(U + (size_t)(sample ? row0 + r - (CW - 1) : sq * SEQ + i) * MIXB + 2 * cp);
                val[0] = __uint_as_float(raw << 16); val[1] = __uint_as_float(raw & 0xffff0000u); }
#pragma unroll
            for (int t = 0; t < TT; ++t) { const int j = r - t; if (j >= 0 && j < CW) acc[t] += w[j] * val; }
        }
#pragma unroll
        for (int t = 0; t < TT; ++t) *(f32x2v*)(zb + t * MIXB + 2 * cp) = acc[t];
    }
    LDS_BARRIER();
    if (tile >= 0) {
#pragma unroll
        for (int tt = 0; tt < TT / 4; ++tt) { const int t = wq * (TT / 4) + tt;
            const f32x4 z0 = *(const f32x4*)(zb + t * MIXB + 8 * lane), z1 = *(const f32x4*)(zb + t * MIXB + 8 * lane + 4);
            const float s1 = wave_sum((z0[0] + z0[1]) + (z0[2] + z0[3]) + (z1[0] + z1[1]) + (z1[2] + z1[3]));
            const float mu = s1 * (1.0f / MIXB); const f32x4 d0 = z0 - mu, d1 = z1 - mu;
            const float s2 = wave_sum((d0[0] * d0[0] + d0[1] * d0[1]) + (d0[2] * d0[2] + d0[3] * d0[3]) + (d1[0] * d1[0] + d1[1] * d1[1]) + (d1[2] * d1[2] + d1[3] * d1[3]));
            const float rstd = rsqrtf(s2 * (1.0f / MIXB) + EPS);
            f32x4 y0 = d0 * rstd * g0 + b0, y1 = d1 * rstd * g1 + b1;
#pragma unroll
            for (int j = 0; j < 4; ++j) { y0[j] = siluf_(y0[j]); y1[j] = siluf_(y1[j]); }
            u32x4 o; o.x = cvt_pk_bf16(y0[0], y0[1]); o.y = cvt_pk_bf16(y0[2], y0[3]); o.z = cvt_pk_bf16(y1[0], y1[1]); o.w = cvt_pk_bf16(y1[2], y1[3]);
            *(u32x4*)(CAT + (size_t)(row0 + t) * DM + MIXA + 8 * lane) = o; }
    }
    LDS_BARRIER();
}

constexpr int CONV_MOVED = NB * HEADS * 8;
static_assert(CONV_MOVED <= NB * (SEQ / 16) / 2, "conv split");
constexpr int LDS_BYTES = LDS_MAIN + 256;
__global__ void __launch_bounds__(512, 2) hymba_fwd(Params p) {
    extern __shared__ __attribute__((aligned(16))) unsigned char lds[];
    cg::grid_group grid = cg::this_grid();
    unsigned char* ws = p.ws;
    PG8_LAS unsigned char* glds = (PG8_LAS unsigned char*)lds;
    const int G = gridDim.x, bx = blockIdx.x;
    if (p.ws == nullptr) grid.sync();
    volatile XLAS unsigned* xst = (volatile XLAS unsigned*)(glds + LDS_MAIN);
    if (threadIdx.x < 4) xst[threadIdx.x] = 0u;
    __syncthreads();
    const XcdBarrier gbar = xcd_barrier_post((unsigned*)(ws + WS_BAR), xst);

    p0_prologue(p, lds);
    xcd_barrier(gbar);
    {
        pg8::Gemm g{(const bf16_t*)(ws + WS_XN), (const bf16_t*)(ws + WS_W1), MT, DIN, DM}; pg8::StaticOrder S; S.init(MP, DIN, G, bx);
        Epi1 E{(bf16_t*)(ws + WS_Q), (bf16_t*)(ws + WS_K), (bf16_t*)(ws + WS_V), (bf16_t*)(ws + WS_G), (bf16_t*)(ws + WS_U), (float*)(ws + WS_LOGF), (const float*)(ws + WS_LB), p.out + O_SCP, p.out + O_SCS};
        pg8::gemm_phase(glds, g, S, E);
        for (int u = bx; u < 16 * 48; u += G) { const int rb = u / 48, ct = u % 48; int br0, br1;
            if (ct < 32) { br0 = ct * 64; br1 = br0 + 32; } else { br0 = 2048 + ((ct - 32) >> 2) * 256 + ((ct - 32) & 3) * 32; br1 = br0 + 128; }
            small_gemm<DM>(lds, g.A, g.Bt, MP + 32 * rb, permcol(br0), permcol(br1), E); }
    }
    xcd_barrier(gbar);
    {
        for (int u = bx; u < NB * HEADS * (NSEG - 1); u += G) hgrn_seg<false>(p, lds, u / (HEADS * (NSEG - 1)), (u / (NSEG - 1)) % HEADS, u % (NSEG - 1));
        for (int u = G - 1 - bx; u < DB * HEADS / 2; u += G) hgrn_sample_pair(p, (float*)lds, 2 * u + (threadIdx.x >> 8));
        for (int u = CONV_MOVED + bx; u < NB * (SEQ / 16) / 2; u += G) conv_pair<16>(p, lds, false, 2 * u + (threadIdx.x >> 8));
        { const int ib = G - 1 - bx, nb2 = G < 32 ? G : 32;
          if (ib < nb2) for (int u = ib; u < DB / 2; u += nb2) conv_pair<DS>(p, lds, true, 2 * u + (threadIdx.x >> 8)); }
    }
    xcd_barrier(gbar);
    {
        for (int u = bx; u < NB * HEADS * NSEG; u += G) { hgrn_seg<true>(p, lds, u >> 5, (u >> 3) & 3, u & 7);
            const int seg = u & 7, ne = seg < 2 ? 2 : (seg < 6 ? 1 : 0), o0 = (int)((0x88765420u >> (4 * seg)) & 15u);
            for (int k = 0; k < ne; ++k) conv_pair<16>(p, lds, false, 2 * ((u >> 3) * 8 + o0 + k) + (threadIdx.x >> 8)); }
    }
    xcd_barrier(gbar);
    {
        pg8::Gemm g{(const bf16_t*)(ws + WS_CAT), (const bf16_t*)(ws + WS_W2), MT, DM, DM}; pg8::StaticOrder S; S.init(MP, DM, G, bx);
        EpiRes<false> E{p.in[I_XP], p.in[I_XS], (bf16_t*)(ws + WS_HB), (float*)(ws + WS_SS1), (bf16_t*)(ws + WS_HB)};
        pg8::gemm_phase(glds, g, S, E);
        for (int u = bx; u < 256; u += G) small_gemm<DM>(lds, g.A, g.Bt, MP + 32 * (u >> 4), (u & 15) * 64, (u & 15) * 64 + 32, E);
    }
    xcd_barrier(gbar);
    {
        pg8::Gemm g{(const bf16_t*)(ws + WS_HB), (const bf16_t*)(ws + WS_W3), MT, 2 * DFF, DM}; OrderFfn S; S.init(G, bx);
        EpiSwi E{(const float*)(ws + WS_SS1), (bf16_t*)(ws + WS_ACT)};
        pg8::gemm_phase(glds, g, S, E);
    }
    xcd_barrier(gbar);
    {
        pg8::Gemm g{(const bf16_t*)(ws + WS_ACT), (const bf16_t*)(ws + WS_W4), MT, DM, DFF}; pg8::StaticOrder S; S.init(MP, DM, G, bx);
        EpiRes<true> E{nullptr, nullptr, (bf16_t*)(ws + WS_HB), (float*)(ws + WS_SS2), (bf16_t*)(ws + WS_HB)};
        pg8::gemm_phase(glds, g, S, E);
        for (int u = bx; u < 256; u += G) small_gemm<DFF>(lds, g.A, g.Bt, MP + 32 * (u >> 4), (u & 15) * 64, (u & 15) * 64 + 32, E);
    }
    xcd_barrier(gbar);
    {
        pg8::StaticOrder S; S.init(MP, DM, G, bx);
        { pg8::Gemm g{(const bf16_t*)(ws + WS_PB), (const bf16_t*)(ws + WS_W6), MT, DM, DPLE}; EpiBf E{(bf16_t*)(ws + WS_PP)}; pg8::gemm_phase(glds, g, S, E);
          for (int u = bx; u < 256; u += G) small_gemm<DPLE>(lds, g.A, g.Bt, MP + 32 * (u >> 4), (u & 15) * 64, (u & 15) * 64 + 32, E);
          asm volatile("s_waitcnt vmcnt(0)" ::: "memory"); }
        { pg8::Gemm g{(const bf16_t*)(ws + WS_HB), (const bf16_t*)(ws + WS_W5), MT, DM, DM}; EpiPle E{(const float*)(ws + WS_SS2), (const bf16_t*)(ws + WS_PP), (const bf16_t*)(ws + WS_HB), (bf16_t*)(ws + WS_H3), (float*)(ws + WS_SS3)}; pg8::gemm_phase(glds, g, S, E);
          for (int u = bx; u < 256; u += G) small_gemm<DM>(lds, g.A, g.Bt, MP + 32 * (u >> 4), (u & 15) * 64, (u & 15) * 64 + 32, E); }
    }
    xcd_barrier(gbar);
    {
        const int lane = threadIdx.x & 63, gw = bx * 8 + (threadIdx.x >> 6), NGW = G * 8;
        const f32x4* gp = (const f32x4*)p.in[I_NFIN] + lane; f32x4 gv[4];
#pragma unroll
        for (int j = 0; j < 4; ++j) gv[j] = gp[64 * j];
        const bf16_t* H3 = (const bf16_t*)(ws + WS_H3); const float* ss3 = (const float*)(ws + WS_SS3);
        for (int m0 = 2 * gw; m0 < MT; m0 += 2 * NGW) { const int m1 = m0 + 1;
            const float r0 = rsqrtf(ss3[m0] * (1.0f / DM) + EPS), r1 = rsqrtf(ss3[m1] * (1.0f / DM) + EPS);
            u32x2 h0[4], h1[4];
#pragma unroll
            for (int j = 0; j < 4; ++j) { h0[j] = __builtin_nontemporal_load((const u32x2*)(H3 + (size_t)m0 * DM) + lane + 64 * j); h1[j] = __builtin_nontemporal_load((const u32x2*)(H3 + (size_t)m1 * DM) + lane + 64 * j); }
#pragma unroll
            for (int j = 0; j < 4; ++j) { __builtin_nontemporal_store(unpack4(h0[j]) * r0 * gv[j], (f32x4*)(p.out + (size_t)m0 * DM) + lane + 64 * j); __builtin_nontemporal_store(unpack4(h1[j]) * r1 * gv[j], (f32x4*)(p.out + (size_t)m1 * DM) + lane + 64 * j); } }
    }
}

extern "C" void kernel_launch(void* const* d_in, const int* in_sizes, int n_in, void* d_out, int out_size, void* d_ws, size_t ws_size, hipStream_t stream) {
    static int grid_blocks = 0;
    if (!grid_blocks) {
        if (n_in != 23 || (size_t)out_size != O_END || ws_size < WS_END) { fprintf(stderr, "kernel_launch: unexpected shapes: n_in %d out %d (want %zu) ws %zu (need %zu)\n", n_in, out_size, (size_t)O_END, ws_size, (size_t)WS_END); }
        int dev = 0, cus = 0, per_cu = 0;
        hipGetDevice(&dev); hipDeviceGetAttribute(&cus, hipDeviceAttributeMultiprocessorCount, dev);
        hipFuncSetAttribute((const void*)hymba_fwd, hipFuncAttributeMaxDynamicSharedMemorySize, LDS_BYTES);
        hipOccupancyMaxActiveBlocksPerMultiprocessor(&per_cu, (const void*)hymba_fwd, 512, LDS_BYTES);
        if (per_cu < 1) { fprintf(stderr, "kernel_launch: occupancy query says %d blocks per CU\n", per_cu); per_cu = 1; }
        grid_blocks = cus;
    }
    Params p{};
    for (int i = 0; i < 23; ++i) p.in[i] = (const float*)d_in[i];
    p.out = (float*)d_out; p.ws = (unsigned char*)d_ws;
    if (hipMemsetAsync((char*)d_ws + WS_BAR, 0, WS_BAR_BYTES, stream) != hipSuccess) fprintf(stderr, "kernel_launch: memset of the barrier words failed\n");
    void* args[] = {&p};
    hipError_t e = hipLaunchCooperativeKernel((const void*)hymba_fwd, dim3(grid_blocks), dim3(512), args, LDS_BYTES, stream);
    if (e != hipSuccess) fprintf(stderr, "cooperative launch failed: %s (grid %d)\n", hipGetErrorString(e), grid_blocks);
}
```
